# Optimizing an MI355X kernel written in HIP

```python
import math
import jax, jax.numpy as jnp
from jax import lax
import numpy as np

D_MODEL = 1024
BATCH = 16
SEQ = 4096
DEPTH = 2

EPS = 1e-6
ROPE_THETA = 10000.0
BLOCK_Q = 128
RET_HEADS = 4
RET_DK = 64
RET_DV = 128
RET_CHUNK = 128
FOX_HEADS = 4
FOX_DH = 128
MLA_HEADS = 4
MLA_Q_RANK = 256
MLA_KV_RANK = 128
MLA_NOPE = 128
MLA_ROPE = 64
MLA_V = 128
N_BRANCH = 3
BRANCH_W = 512
N_GROUPS = 4
EXP_PER_GROUP = 8
N_EXPERTS = N_GROUPS * EXP_PER_GROUP
TOP_K = 2
D_EXPERT = 512
MOE_BLOCK = 128

IN_SIZES = (RET_HEADS * RET_DK, RET_HEADS * RET_DK, RET_HEADS * RET_DV, RET_HEADS * RET_DV,
            FOX_HEADS * FOX_DH, FOX_HEADS * FOX_DH, FOX_HEADS * FOX_DH, FOX_HEADS,
            MLA_Q_RANK, MLA_KV_RANK, MLA_ROPE)
IN_OFFSETS = tuple(sum(IN_SIZES[:i + 1]) for i in range(len(IN_SIZES) - 1))
D_IN = sum(IN_SIZES)

kernel_name = "hybrid_retention_fox_mla_hiermoe_adaln"


def rms_norm(x, g):
    xf = x.astype(jnp.float32)
    y = xf * lax.rsqrt(jnp.mean(xf * xf, axis=-1, keepdims=True) + EPS)
    return (y * g.astype(jnp.float32)).astype(x.dtype)


def modulate(h, shift, scale):
    return h * (1 + scale[:, None, :]) + shift[:, None, :]


def rope(x, positions):
    d = x.shape[-1]
    inv = ROPE_THETA ** (-jnp.arange(0, d, 2, dtype=jnp.float32) / d)
    ang = positions.astype(jnp.float32)[..., None] * inv
    cos = jnp.cos(ang)[:, :, None, :]
    sin = jnp.sin(ang)[:, :, None, :]
    xf = x.astype(jnp.float32)
    x1, x2 = xf[..., : d // 2], xf[..., d // 2:]
    return jnp.concatenate([x1 * cos - x2 * sin, x2 * cos + x1 * sin], axis=-1).astype(x.dtype)


def retention(q, k, v, g):
    B, S, H, dk = q.shape
    dv = v.shape[-1]
    C = RET_CHUNK
    N = S // C
    dt = q.dtype
    f32 = jnp.float32
    log_gamma = jnp.log1p(-jnp.exp2(-5.0 - jnp.arange(H, dtype=f32)))
    idx = jnp.arange(C, dtype=f32)
    rel = idx[:, None] - idx[None, :]
    dmask = jnp.where(rel >= 0, jnp.exp(log_gamma[:, None, None] * jnp.maximum(rel, 0.0)), 0.0)
    decay_in = jnp.exp(log_gamma[:, None] * (idx + 1.0))
    decay_out = jnp.exp(log_gamma[:, None] * (C - 1.0 - idx))
    decay_chunk = jnp.exp(log_gamma * C)
    qc = q.astype(f32).reshape(B, N, C, H, dk)
    kc = (k.astype(f32) * dk ** -0.5).reshape(B, N, C, H, dk)
    vc = v.astype(f32).reshape(B, N, C, H, dv)
    scores = jnp.einsum('bnchd,bnmhd->bhncm', qc, kc) * dmask[None, :, None]
    inner = jnp.einsum('bhncm,bnmhe->bnche', scores, vc)
    kv = jnp.einsum('bnmhd,hm,bnmhe->nbhde', kc, decay_out, vc)

    def step(state, kv_n):
        return state * decay_chunk[None, :, None, None] + kv_n, state

    _, s_prev = lax.scan(step, jnp.zeros((B, H, dk, dv), f32), kv)
    cross = jnp.einsum('bnchd,hc,nbhde->bnche', qc, decay_in, s_prev)
    o = (inner + cross).reshape(B, S, H, dv)
    mu = jnp.mean(o, axis=-1, keepdims=True)
    var = jnp.mean(jnp.square(o - mu), axis=-1, keepdims=True)
    o = ((o - mu) * lax.rsqrt(var + EPS)).reshape(B, S, H * dv)
    return (jax.nn.silu(g.astype(f32)) * o).astype(dt)


def blocked_causal_attention(q, k, v, log_f_cum=None):
    B, S, H, d = q.shape
    dv = v.shape[-1]
    NQ = S // BLOCK_Q
    scale = d ** -0.5
    kpos = jnp.arange(S)
    qb = q.reshape(B, NQ, BLOCK_Q, H, d).transpose(1, 0, 2, 3, 4)
    blk_ids = jnp.arange(NQ)
    use_forget = log_f_cum is not None
    if use_forget:
        fk = log_f_cum.transpose(0, 2, 1)
        fq = log_f_cum.reshape(B, NQ, BLOCK_Q, H).transpose(1, 0, 3, 2)
        xs = (qb, blk_ids, fq)
    else:
        xs = (qb, blk_ids)

    def body(args):
        qblk, bi = args[0], args[1]
        s = jnp.einsum('bqhd,bkhd->bhqk', qblk, k).astype(jnp.float32) * scale
        if use_forget:
            s = s + args[2][..., None] - fk[:, :, None, :]
        qpos = bi * BLOCK_Q + jnp.arange(BLOCK_Q)
        s = jnp.where(kpos[None, :] <= qpos[:, None], s, -jnp.inf)
        p = jax.nn.softmax(s, axis=-1)
        return jnp.einsum('bhqk,bkhe->bqhe', p.astype(v.dtype), v)

    out = lax.map(body, xs)
    return out.transpose(1, 0, 2, 3, 4).reshape(B, S, H * dv)


def token_mixer(h, positions, w_in, fox_fb, mla_q_norm_g, mla_wq_up, mla_kv_norm_g, mla_wkv_up,
                gate_w, gate_b, branch_w, out_w):
    B, S, D = h.shape
    proj = h @ w_in
    rq, rk, rv, rg, fq, fk, fv, ff, mq, mkv, mkr = jnp.split(proj, IN_OFFSETS, axis=-1)
    rq = rope(rq.reshape(B, S, RET_HEADS, RET_DK), positions)
    rk = rope(rk.reshape(B, S, RET_HEADS, RET_DK), positions)
    ya = retention(rq, rk, rv.reshape(B, S, RET_HEADS, RET_DV), rg)
    log_f = jax.nn.log_sigmoid((ff + fox_fb).astype(jnp.float32))
    f_cum = jnp.cumsum(log_f, axis=1)
    yb = blocked_causal_attention(fq.reshape(B, S, FOX_HEADS, FOX_DH),
                                  fk.reshape(B, S, FOX_HEADS, FOX_DH),
                                  fv.reshape(B, S, FOX_HEADS, FOX_DH), f_cum)
    qh = (rms_norm(mq, mla_q_norm_g) @ mla_wq_up).reshape(B, S, MLA_HEADS, MLA_NOPE + MLA_ROPE)
    q_nope, q_pe = qh[..., :MLA_NOPE], rope(qh[..., MLA_NOPE:], positions)
    kvh = (rms_norm(mkv, mla_kv_norm_g) @ mla_wkv_up).reshape(B, S, MLA_HEADS, MLA_NOPE + MLA_V)
    k_nope, v_c = kvh[..., :MLA_NOPE], kvh[..., MLA_NOPE:]
    k_pe = jnp.broadcast_to(rope(mkr[:, :, None, :], positions), (B, S, MLA_HEADS, MLA_ROPE))
    yc = blocked_causal_attention(jnp.concatenate([q_nope, q_pe], axis=-1),
                                  jnp.concatenate([k_nope, k_pe], axis=-1), v_c)
    gates = jax.nn.sigmoid((h @ gate_w + gate_b).astype(jnp.float32)).astype(h.dtype)
    gates = gates.reshape(B, S, N_BRANCH, D)
    merged = gates[:, :, 0] * (ya @ branch_w[0])
    merged = merged + gates[:, :, 1] * (yb @ branch_w[1])
    merged = merged + gates[:, :, 2] * (yc @ branch_w[2])
    return merged @ out_w


def hier_moe(h, w_grp, b_grp, w_exp, b_exp, w1, w3, w2):
    B, S, D = h.shape
    T = B * S
    f32 = jnp.float32
    t = h.reshape(T, D)
    tf = t.astype(f32)
    grp_p = jax.nn.softmax(tf @ w_grp.astype(f32) + b_grp.astype(f32), axis=-1)
    g_idx = jnp.argmax(grp_p, axis=-1)
    g_w = jnp.max(grp_p, axis=-1)
    exp_logits = (tf @ w_exp.astype(f32) + b_exp.astype(f32)).reshape(T, N_GROUPS, EXP_PER_GROUP)
    in_grp = jnp.take_along_axis(exp_logits, g_idx[:, None, None], axis=1)[:, 0]
    top_p, top_i = lax.top_k(jax.nn.softmax(in_grp, axis=-1), TOP_K)
    top_p = top_p / jnp.sum(top_p, axis=-1, keepdims=True)
    eid = (g_idx[:, None] * EXP_PER_GROUP + top_i).reshape(-1).astype(jnp.int32)
    wts = (g_w[:, None] * top_p).reshape(-1)
    tok = jnp.repeat(jnp.arange(T, dtype=jnp.int32), TOP_K)
    A = T * TOP_K
    order = jnp.argsort(eid)
    se, stok, sw = eid[order], tok[order], wts[order]
    counts = jnp.bincount(eid, length=N_EXPERTS)
    starts = jnp.cumsum(counts) - counts
    pcounts = (counts + MOE_BLOCK - 1) // MOE_BLOCK * MOE_BLOCK
    pends = jnp.cumsum(pcounts)
    pstarts = pends - pcounts
    dest = pstarts[se] + jnp.arange(A) - starts[se]
    n_blocks = -(-A // MOE_BLOCK) + N_EXPERTS
    P = n_blocks * MOE_BLOCK
    buf_tok = jnp.zeros((P,), jnp.int32).at[dest].set(stok)
    buf_w = jnp.zeros((P,), f32).at[dest].set(sw)
    blk_e = jnp.minimum(jnp.searchsorted(pends, jnp.arange(n_blocks) * MOE_BLOCK, side='right'),
                        N_EXPERTS - 1)

    def expert_block(args):
        tok_b, w_b, e = args
        xb = t[tok_b]
        hid = jax.nn.silu(xb @ w1[e]) * (xb @ w3[e])
        return (hid @ w2[e]) * w_b[:, None].astype(t.dtype)

    ys = lax.map(expert_block, (buf_tok.reshape(n_blocks, MOE_BLOCK),
                                buf_w.reshape(n_blocks, MOE_BLOCK), blk_e))
    out = jnp.zeros((T, D), t.dtype).at[buf_tok].add(ys.reshape(P, D))
    return out.reshape(B, S, D)


def setup_inputs(seed: int = 0) -> dict:
    key = jax.random.key(seed)
    ks = jax.random.split(key, 26)
    L, D = DEPTH, D_MODEL
    f32 = jnp.float32

    def nrm(k, shape, fan_in, mult=1.0):
        return jax.random.normal(k, shape, f32) * (mult * fan_in ** -0.5)

    def gain(k, shape):
        return 1.0 + 0.05 * jax.random.normal(k, shape, f32)

    def small(k, shape, s=0.02):
        return s * jax.random.normal(k, shape, f32)

    positions = (jnp.arange(SEQ, dtype=jnp.int32)[None, :]
                 + jax.random.randint(ks[2], (BATCH, 1), 0, 1024, dtype=jnp.int32))
    return {
        "x": jax.random.normal(ks[0], (BATCH, SEQ, D), f32),
        "c": jax.random.normal(ks[1], (BATCH, D), f32),
        "positions": positions,
        "ada_w": nrm(ks[3], (L, D, 6 * D), D, 0.5),
        "ada_b": small(ks[4], (L, 6 * D)),
        "norm1_g": gain(ks[5], (L, D)),
        "norm2_g": gain(ks[6], (L, D)),
        "w_in": nrm(ks[7], (L, D, D_IN), D),
        "fox_fb": 1.0 + 0.5 * jax.random.normal(ks[8], (L, FOX_HEADS), f32),
        "mla_q_norm_g": gain(ks[9], (L, MLA_Q_RANK)),
        "mla_wq_up": nrm(ks[10], (L, MLA_Q_RANK, MLA_HEADS * (MLA_NOPE + MLA_ROPE)), MLA_Q_RANK),
        "mla_kv_norm_g": gain(ks[11], (L, MLA_KV_RANK)),
        "mla_wkv_up": nrm(ks[12], (L, MLA_KV_RANK, MLA_HEADS * (MLA_NOPE + MLA_V)), MLA_KV_RANK),
        "gate_w": nrm(ks[13], (L, D, N_BRANCH * D), D),
        "gate_b": small(ks[14], (L, N_BRANCH * D)),
        "branch_w": nrm(ks[15], (L, N_BRANCH, BRANCH_W, D), BRANCH_W),
        "out_w": nrm(ks[16], (L, D, D), D),
        "router_grp_w": nrm(ks[17], (L, D, N_GROUPS), D),
        "router_grp_b": small(ks[18], (L, N_GROUPS), 0.01),
        "router_exp_w": nrm(ks[19], (L, D, N_EXPERTS), D),
        "router_exp_b": small(ks[20], (L, N_EXPERTS), 0.01),
        "exp_w1": nrm(ks[21], (L, N_EXPERTS, D, D_EXPERT), D),
        "exp_w3": nrm(ks[22], (L, N_EXPERTS, D, D_EXPERT), D),
        "exp_w2": nrm(ks[23], (L, N_EXPERTS, D_EXPERT, D), D_EXPERT),
        "final_g": gain(ks[24], (D,)),
    }


def reference(x, c, positions, ada_w, ada_b, norm1_g, norm2_g, w_in, fox_fb, mla_q_norm_g,
              mla_wq_up, mla_kv_norm_g, mla_wkv_up, gate_w, gate_b, branch_w, out_w,
              router_grp_w, router_grp_b, router_exp_w, router_exp_b, exp_w1, exp_w3, exp_w2,
              final_g):
    c_act = jax.nn.silu(c)
    for l in range(DEPTH):
        mod = c_act @ ada_w[l] + ada_b[l]
        sh1, sc1, gt1, sh2, sc2, gt2 = jnp.split(mod, 6, axis=-1)
        h = modulate(rms_norm(x, norm1_g[l]), sh1, sc1)
        mix = token_mixer(h, positions, w_in[l], fox_fb[l], mla_q_norm_g[l], mla_wq_up[l],
                          mla_kv_norm_g[l], mla_wkv_up[l], gate_w[l], gate_b[l], branch_w[l], out_w[l])
        x = x + gt1[:, None, :] * mix
        h = modulate(rms_norm(x, norm2_g[l]), sh2, sc2)
        ffn = hier_moe(h, router_grp_w[l], router_grp_b[l], router_exp_w[l], router_exp_b[l],
                       exp_w1[l], exp_w3[l], exp_w2[l])
        x = x + gt2[:, None, :] * ffn
    return rms_norm(x, final_g)
```

```cpp
#include <hip/hip_runtime.h>
#include <stdint.h>
#include <stdio.h>

typedef unsigned short u16;
typedef short bf16x8 __attribute__((ext_vector_type(8)));
typedef float f32x4 __attribute__((ext_vector_type(4)));
typedef unsigned u32x2 __attribute__((ext_vector_type(2)));
typedef unsigned u32x4 __attribute__((ext_vector_type(4)));
#define LAS __attribute__((address_space(3)))
#define DEVINL __device__ __forceinline__

constexpr int T_ = 65536, DM = 1024, NBATCH = 16, SEQ = 4096, NTHR = 512;
constexpr int PROWS = 131072 + 32 * 256;
constexpr float EPS = 1e-6f;

enum { I_X = 0, I_C, I_POS, I_ADAW, I_ADAB, I_N1G, I_N2G, I_WIN, I_FOXFB, I_MQG, I_WQUP, I_MKVG, I_WKVUP, I_GATEW, I_GATEB,
       I_BRW, I_OUTW, I_RGW, I_RGB, I_REW, I_REB, I_W1, I_W3, I_W2, I_FING };

constexpr size_t MB = 1ull << 20;
constexpr size_t WS_CTL = 0, WS_MOD = 1 * MB, WS_FCUM = 2 * MB, WS_FFL = 3 * MB, WS_ROUTE = 4 * MB, WS_TOKL = 6 * MB, WS_WL = 7 * MB,
                 WS_ROPE = 8 * MB, WS_WIN = 24 * MB, WS_GATE = 31 * MB, WS_BR = 37 * MB, WS_OUTW = 40 * MB, WS_WQ = 42 * MB,
                 WS_WKV = 43 * MB, WS_W13 = 44 * MB, WS_W2 = 108 * MB, WS_H = 140 * MB, WS_RQK = 268 * MB, WS_RV = 332 * MB,
                 WS_RG = 396 * MB, WS_FQ = 460 * MB, WS_FK = 524 * MB, WS_FV = 588 * MB, WS_MQ = 652 * MB, WS_MKV = 684 * MB,
                 WS_KPE = 700 * MB, WS_Q = 708 * MB, WS_KV = 804 * MB, WS_END = 932 * MB,
                 WS_HID = 268 * MB, WS_YEXP = 404 * MB, WS_MERGED = WS_H,
                 WS_FVT = WS_FV, WS_RVT = WS_RV, WS_KN = WS_KV, WS_MVT = WS_KV + 64 * MB, WS_XM = WS_KV,

                 WS_YC = 932 * MB, WS_G0 = WS_RQK, WS_G1 = WS_FK, WS_G2 = WS_KV, WS_RTAB = 996 * MB, WS_RCJ = 1003 * MB, WS_END2 = 1004 * MB,
                 WS_H8A = WS_W13 + 32 * MB, WS_H8B = WS_MQ;
constexpr size_t CTL_ZERO_BYTES = 64 * 1024;
constexpr int CW_CNT = 4096;
constexpr int CW_KMAX = 4224;

constexpr int LDS_BYTES = 146 * 1024;

struct Params { const float* in[25]; float* out; unsigned char* ws; int ph_lo, ph_hi; };

DEVINL float bf2f(u16 v) { return __uint_as_float(((unsigned)v) << 16); }
DEVINL u16 f2bf(float f) { unsigned u = __float_as_uint(f); u += 0x7FFFu + ((u >> 16) & 1u); return (u16)(u >> 16); }
typedef float f32x2 __attribute__((ext_vector_type(2)));
typedef __bf16 bf16x2_t __attribute__((ext_vector_type(2)));
DEVINL unsigned pk2(float lo, float hi) { f32x2 v = {lo, hi}; bf16x2_t b = __builtin_convertvector(v, bf16x2_t); return *reinterpret_cast<unsigned*>(&b); }
typedef int v8i __attribute__((ext_vector_type(8)));
typedef int v4i __attribute__((ext_vector_type(4)));
DEVINL unsigned pk4_f8(float a, float b, float c, float d) { int w = __builtin_amdgcn_cvt_pk_fp8_f32(a, b, 0, false); w = __builtin_amdgcn_cvt_pk_fp8_f32(c, d, w, true); return (unsigned)w; }
DEVINL float lo2f(unsigned v) { return __uint_as_float(v << 16); }
DEVINL float hi2f(unsigned v) { return __uint_as_float(v & 0xFFFF0000u); }
DEVINL float wsum(float v) { for (int o = 32; o; o >>= 1) v += __shfl_xor(v, o); return v; }
DEVINL float sigmoidf_(float x) { return __builtin_amdgcn_rcpf(1.f + __builtin_amdgcn_exp2f(x * -1.4426950408889634f)); }
DEVINL float siluf_(float x) { return x * __builtin_amdgcn_rcpf(1.f + __builtin_amdgcn_exp2f(x * -1.4426950408889634f)); }

__device__ const float ROPE_INV[32] = {
    1.000000000e+00f, 7.498942614e-01f, 5.623413324e-01f, 4.216965139e-01f, 3.162277639e-01f, 2.371373773e-01f, 1.778279394e-01f, 1.333521307e-01f,
    1.000000015e-01f, 7.498941571e-02f, 5.623413250e-02f, 4.216965288e-02f, 3.162277490e-02f, 2.371373773e-02f, 1.778279431e-02f, 1.333521493e-02f,
    9.999999776e-03f, 7.498941850e-03f, 5.623413250e-03f, 4.216964822e-03f, 3.162277630e-03f, 2.371373586e-03f, 1.778279431e-03f, 1.333521446e-03f,
    1.000000047e-03f, 7.498942432e-04f, 5.623413017e-04f, 4.216965172e-04f, 3.162277571e-04f, 2.371373703e-04f, 1.778279402e-04f, 1.333521504e-04f};

#define XB_TMO      128
#define XB_XCNT(j)  (256  + 64 * (j))
#define XB_XSUB(j)  (1280 + 64 * (j))
#define XB_XGEN(j)  (2304 + 64 * (j))
#define XB_TOP      3328
#define XB_TOPGEN   3392
#define XCD_BAR_WORDS 3456
#define XB_SPIN_CAP (1u << 20)

__device__ __forceinline__ unsigned xb_ld(unsigned* p)              { return __hip_atomic_load(p, __ATOMIC_RELAXED, __HIP_MEMORY_SCOPE_AGENT); }
__device__ __forceinline__ unsigned xb_add(unsigned* p, unsigned v) { return __hip_atomic_fetch_add(p, v, __ATOMIC_RELAXED, __HIP_MEMORY_SCOPE_AGENT); }
__device__ __forceinline__ unsigned xb_xcc_id() { return (unsigned)__builtin_amdgcn_s_getreg((3 << 11) | 20) & 0xFu; }
#define XB_SPIN(cond, bar) do { unsigned _sp = 0; while (cond) { __builtin_amdgcn_s_sleep(1); \
    if ((++_sp & 255u) == 0u) { if (xb_ld(&(bar)[XB_TMO])) break; if (_sp > XB_SPIN_CAP) { atomicAdd(&(bar)[XB_TMO], 1u); break; } } } } while (0)

struct XcdBarrier { unsigned* bar; unsigned x; volatile LAS unsigned* st; };

__device__ __forceinline__ XcdBarrier xcd_barrier_post(unsigned* bar, volatile LAS unsigned* st) {
    XcdBarrier b; b.bar = bar; b.x = xb_xcc_id(); b.st = st;
    if (threadIdx.x == 0) (void)xb_add(&bar[XB_XCNT(b.x)], 1u);
    return b;
}
__device__ __forceinline__ void xcd_barrier_complete(unsigned* bar, unsigned x, unsigned& nloc, unsigned& nx) {
    const unsigned G = gridDim.x * gridDim.y * gridDim.z;
    unsigned sum, cnt, mine, sp = 0u;
    for (;;) {
        sum = 0u; cnt = 0u; mine = 0u;
#pragma unroll
        for (unsigned j = 0; j < 16; ++j) { const unsigned c = xb_ld(&bar[XB_XCNT(j)]); sum += c; cnt += (c > 0u) ? 1u : 0u; mine = (j == x) ? c : mine; }
        if (sum == G) break;
        __builtin_amdgcn_s_sleep(1);
        if ((++sp & 255u) == 0u) { if (xb_ld(&bar[XB_TMO])) break; if (sp > XB_SPIN_CAP) { atomicAdd(&bar[XB_TMO], 1u); break; } }
    }
    nloc = mine > 0u ? mine : 1u; nx = cnt > 0u ? cnt : 1u;
}
__device__ __forceinline__ void xcd_barrier(const XcdBarrier& b) {
    asm volatile("s_waitcnt vmcnt(0)" ::: "memory");
    __syncthreads();
    if (threadIdx.x == 0) {
        unsigned* bar = b.bar;
        __builtin_amdgcn_s_waitcnt(0);
        unsigned nloc = b.st[0], nx = b.st[1];
        if (nloc == 0u) { xcd_barrier_complete(bar, b.x, nloc, nx); b.st[0] = nloc; b.st[1] = nx; }
        const unsigned old = xb_add(&bar[XB_XSUB(b.x)], 1u);
        const unsigned gen = old / nloc;
        if (old + 1u == (gen + 1u) * nloc) {
            __builtin_amdgcn_fence(__ATOMIC_RELEASE, "agent");
            asm volatile("s_waitcnt vmcnt(0)" ::: "memory");
            const unsigned og = xb_add(&bar[XB_TOP], 1u);
            const unsigned tg = og / nx;
            if (og + 1u == (tg + 1u) * nx) xb_add(&bar[XB_TOPGEN], 1u);
            else XB_SPIN(xb_ld(&bar[XB_TOPGEN]) == tg, bar);
            __builtin_amdgcn_fence(__ATOMIC_ACQUIRE, "agent");
            xb_add(&bar[XB_XGEN(b.x)], 1u);
            asm volatile("s_waitcnt vmcnt(0)" ::: "memory");
        } else {
            XB_SPIN(xb_ld(&bar[XB_XGEN(b.x)]) == gen, bar);
            __builtin_amdgcn_fence(__ATOMIC_ACQUIRE, "agent");
            asm volatile("s_waitcnt vmcnt(0)" ::: "memory");
        }
    }
    __syncthreads();
}

DEVINL int BID() { int b = blockIdx.x; asm volatile("" : "+s"(b)); return b; }
DEVINL int TID() { int t = threadIdx.x; asm volatile("" : "+v"(t)); return t; }
DEVINL unsigned char* WSP(const Params& p) { unsigned char* w = p.ws; asm volatile("" : "+s"(w)); return w; }

DEVINL void ph_mod(const Params& p, LAS unsigned char* lds) {
    LAS float* cact = (LAS float*)lds;
    LAS float* red = (LAS float*)(lds + 65536);
    const int tid = TID(), lane = tid & 63, wave = tid >> 6;
    if ((int)blockIdx.x >= 48) return;
    const float* c = p.in[I_C];
#pragma unroll 8
    for (int i = tid; i < 16 * 1024; i += NTHR) cact[i] = siluf_(c[i]);
    __syncthreads();
    float* mod = (float*)(WSP(p) + WS_MOD);
    for (int u = blockIdx.x; u < 48; u += gridDim.x) {
        const int l = u / 24, cb = u % 24;
        const float* w = p.in[I_ADAW] + (size_t)l * 1024 * 6144 + cb * 256 + lane * 4;
        float acc[16][4];
#pragma unroll
        for (int bb = 0; bb < 16; ++bb) { acc[bb][0] = 0.f; acc[bb][1] = 0.f; acc[bb][2] = 0.f; acc[bb][3] = 0.f; }
#pragma unroll 1
        for (int k0 = wave * 128; k0 < wave * 128 + 128; k0 += 4) {
            float4 wv[4];
#pragma unroll
            for (int j = 0; j < 4; ++j) wv[j] = *(const float4*)(w + (size_t)(k0 + j) * 6144);
#pragma unroll
            for (int j = 0; j < 4; ++j)
#pragma unroll
                for (int bb = 0; bb < 16; ++bb) { const float cv = cact[bb * 1024 + k0 + j]; acc[bb][0] += cv * wv[j].x; acc[bb][1] += cv * wv[j].y; acc[bb][2] += cv * wv[j].z; acc[bb][3] += cv * wv[j].w; }
        }
#pragma unroll
        for (int rnd = 0; rnd < 2; ++rnd) {
#pragma unroll
            for (int bb = 0; bb < 8; ++bb) *(LAS f32x4*)(red + ((wave * 8 + bb) * 256 + lane * 4)) = f32x4{acc[rnd * 8 + bb][0], acc[rnd * 8 + bb][1], acc[rnd * 8 + bb][2], acc[rnd * 8 + bb][3]};
            __syncthreads();
            for (int o = tid; o < 8 * 256; o += NTHR) {
                const int bb = o >> 8, jj = o & 255;
                float sum = 0.f;
#pragma unroll
                for (int q = 0; q < 8; ++q) sum += red[(q * 8 + bb) * 256 + jj];
                const int jg = cb * 256 + jj;
                mod[((size_t)l * 16 + rnd * 8 + bb) * 6144 + jg] = sum + p.in[I_ADAB][l * 6144 + jg];
            }
            __syncthreads();
        }
    }
}

DEVINL void ph_rope_table(const Params& p) {
    const int* pos = (const int*)p.in[I_POS];
    float2* tab = (float2*)(WSP(p) + WS_ROPE);
    for (int idx = blockIdx.x * NTHR + TID(); idx < T_ * 32; idx += gridDim.x * NTHR) {
        const int t = idx >> 5, i = idx & 31;
        const float ang = (float)pos[t] * ROPE_INV[i];
        const double a = (double)ang;
        const double k = rint(a * 0.15915494309189535);
        const double r = a - k * 6.283185307179586;
        const double q = rint(r * 0.6366197723675814);
        const double y = r - q * 1.5707963267948966;
        const double y2 = y * y;
        const double sn = y * (1.0 + y2 * (-1.0 / 6 + y2 * (1.0 / 120 + y2 * (-1.0 / 5040 + y2 * (1.0 / 362880 + y2 * (-1.0 / 39916800))))));
        const double cs = 1.0 + y2 * (-0.5 + y2 * (1.0 / 24 + y2 * (-1.0 / 720 + y2 * (1.0 / 40320 + y2 * (-1.0 / 3628800 + y2 * (1.0 / 479001600))))));
        const int qi = ((int)q) & 3;
        double co, si;
        if (qi == 0) { co = cs; si = sn; } else if (qi == 1) { co = -sn; si = cs; } else if (qi == 2) { co = -cs; si = -sn; } else { co = sn; si = -cs; }
        tab[idx] = make_float2((float)co, (float)si);
    }
}

DEVINL int p8(int n) { return (n & ~31) + ((n >> 2) & 1) * 16 + ((n >> 3) & 3) * 4 + (n & 3); }
DEVINL int rope_pos(int i) { return i < 32 ? ((i >> 4) * 32 + (i & 15)) : (((i - 32) >> 4) * 32 + 16 + ((i - 32) & 15)); }
template <int MAP> DEVINL int nmap(int n) {
    if (MAP == 1) {
        if (n < 512) return (n & ~63) + rope_pos(n & 63);
        if (n < 1024) return n;
        if (n < 2560) return p8(n);
        if (n < 3072) return n;
        if (n < 3076) return 3520 + (n - 3072);
        if (n < 3460) return p8(n - 4);
        return 3456 + rope_pos(n - 3460);
    }
    if (MAP == 4) { const int hh = n / 192, w = n - hh * 192; return w < 128 ? p8(n) : hh * 192 + 128 + rope_pos(w - 128); }
    if (MAP == 5) { const int hh = n >> 8, c = n & 255; return c < 128 ? p8(hh * 128 + c) : 512 + hh * 128 + (c - 128); }
    if (MAP == 2) return (n >> 7) * 256 + ((n >> 2) & 1) * 128 + ((n >> 5) & 3) * 32 + ((n >> 3) & 3) * 4 + (n & 3);
    if (MAP == 3) return (n >> 7) * 256 + ((n >> 2) & 1) * 128 + ((n >> 5) & 3) * 32 + 16 + ((n >> 3) & 3) * 4 + (n & 3);
    if (MAP == 6) return p8(n);
    if (MAP == 7) { const int c = n & 255; return (n & ~255) + ((c >> 3) & 1) * 128 + (c >> 6) * 32 + ((c >> 2) & 1) * 16 + ((c >> 4) & 3) * 4 + (c & 3); }
    return n;
}
constexpr float W8_SCALE = 64.f;
template <int MAP, bool F8>
DEVINL void conv_wx(const float* src, int nb, int K, int N, int Ntiles64, void* dst, size_t dst_bstride, LAS unsigned char* lds) {
    LAS float* tile = (LAS float*)lds;
    const int tid = TID(), c = tid & 63, r0 = tid >> 6;
    const int kt_n = K / 128, per_b = kt_n * Ntiles64, total = nb * per_b;
    float ld[16];
    int u = blockIdx.x;
#define CONV_LOAD(uu) do { const int b_ = (uu) / per_b, rem_ = (uu) % per_b, kt_ = rem_ / Ntiles64, nt_ = rem_ % Ntiles64; const float* s_ = src + (size_t)b_ * K * N; const int n_ = nt_ * 64 + c; \
        _Pragma("unroll") for (int i = 0; i < 16; ++i) { const int r = r0 + i * 8; ld[i] = (n_ < N) ? s_[(size_t)(kt_ * 128 + r) * N + n_] : 0.f; } } while (0)
    if (u < total) CONV_LOAD(u);
    for (; u < total; u += gridDim.x) {
        const int b = u / per_b, rem = u % per_b, kt = rem / Ntiles64, nt = rem % Ntiles64;
#pragma unroll
        for (int i = 0; i < 16; ++i) tile[(r0 + i * 8) * 65 + c] = F8 ? ld[i] * W8_SCALE : ld[i];
        __syncthreads();
        if (u + (int)gridDim.x < total) CONV_LOAD(u + (int)gridDim.x);
#pragma unroll
        for (int i = 0; i < 2; ++i) {
            const int item = tid + i * NTHR, rn = item >> 4, kg = item & 15, nn = nt * 64 + rn;
            const int drow = (nn < N) ? nmap<MAP>(nn) : nn;
            float v[8];
#pragma unroll
            for (int j = 0; j < 8; ++j) v[j] = tile[(kg * 8 + j) * 65 + rn];
            if constexpr (F8) {
                u32x2 o = {pk4_f8(v[0], v[1], v[2], v[3]), pk4_f8(v[4], v[5], v[6], v[7])};
                *(u32x2*)((unsigned char*)dst + (size_t)b * dst_bstride + (size_t)drow * K + kt * 128 + kg * 8) = o;
            } else {
                u32x4 o = {pk2(v[0], v[1]), pk2(v[2], v[3]), pk2(v[4], v[5]), pk2(v[6], v[7])};
                *(u32x4*)((u16*)dst + (size_t)b * dst_bstride + (size_t)drow * K + kt * 128 + kg * 8) = o;
            }
        }
        __syncthreads();
    }
#undef CONV_LOAD
}
template <int MAP> DEVINL void conv_w(const float* src, int nb, int K, int N, int Ntiles64, u16* dst, size_t dst_bstride, LAS unsigned char* lds) { conv_wx<MAP, false>(src, nb, K, N, Ntiles64, dst, dst_bstride, lds); }
template <int MAP> DEVINL void conv_w8(const float* src, int nb, int K, int N, int Ntiles64, unsigned char* dst, size_t dst_bstride, LAS unsigned char* lds) { conv_wx<MAP, true>(src, nb, K, N, Ntiles64, dst, dst_bstride, lds); }
DEVINL void ph_conv_layer(const Params& p, int l, LAS unsigned char* lds) {
    unsigned char* ws = WSP(p);
    conv_w<1>(p.in[I_WIN] + (size_t)l * 1024 * 3524, 1, 1024, 3524, 56, (u16*)(ws + WS_WIN), 0, lds);
    conv_w8<7>(p.in[I_GATEW] + (size_t)l * 1024 * 3072, 1, 1024, 3072, 48, ws + WS_GATE, 0, lds);
    conv_w<7>(p.in[I_BRW] + (size_t)l * 3 * 512 * 1024, 3, 512, 1024, 16, (u16*)(ws + WS_BR), (size_t)1024 * 512, lds);
    conv_w<7>(p.in[I_OUTW] + (size_t)l * 1024 * 1024, 1, 1024, 1024, 16, (u16*)(ws + WS_OUTW), 0, lds);
    conv_w<4>(p.in[I_WQUP] + (size_t)l * 256 * 768, 1, 256, 768, 12, (u16*)(ws + WS_WQ), 0, lds);
    conv_w<5>(p.in[I_WKVUP] + (size_t)l * 128 * 1024, 1, 128, 1024, 16, (u16*)(ws + WS_WKV), 0, lds);
    conv_w8<2>(p.in[I_W1] + (size_t)l * 32 * 1024 * 512, 32, 1024, 512, 8, ws + WS_W13, (size_t)1024 * 1024, lds);
    conv_w8<3>(p.in[I_W3] + (size_t)l * 32 * 1024 * 512, 32, 1024, 512, 8, ws + WS_W13, (size_t)1024 * 1024, lds);
    conv_w8<7>(p.in[I_W2] + (size_t)l * 32 * 512 * 1024, 32, 512, 1024, 16, ws + WS_W2, (size_t)1024 * 512, lds);
}

DEVINL unsigned char* H8P(const Params& p) { return (unsigned char*)p.out + (size_t)128 * MB; }
DEVINL void norm_consts(const float* g, const float* sh, const float* sc, int b, int lane, float (&gs)[16], float (&sv)[16]) {
#pragma unroll
    for (int i = 0; i < 4; ++i) {
        const int c0 = i * 256 + lane * 4;
        const float4 gv = *(const float4*)(g + c0), shv = *(const float4*)(sh + b * 6144 + c0), scv = *(const float4*)(sc + b * 6144 + c0);
        gs[i * 4 + 0] = gv.x * (1.f + scv.x); gs[i * 4 + 1] = gv.y * (1.f + scv.y); gs[i * 4 + 2] = gv.z * (1.f + scv.z); gs[i * 4 + 3] = gv.w * (1.f + scv.w);
        sv[i * 4 + 0] = shv.x; sv[i * 4 + 1] = shv.y; sv[i * 4 + 2] = shv.z; sv[i * 4 + 3] = shv.w;
    }
}
DEVINL void norm_store_row_f8(unsigned char* Hrow, int lane, const float (&xv)[16], const float (&gs)[16], const float (&sv)[16]) {
    float ss = 0.f;
#pragma unroll
    for (int i = 0; i < 16; ++i) ss += xv[i] * xv[i];
    ss = wsum(ss);
    const float rstd = rsqrtf(ss * (1.f / 1024.f) + EPS);
#pragma unroll
    for (int i = 0; i < 4; ++i)
        *(unsigned*)(Hrow + i * 256 + lane * 4) = pk4_f8(xv[i * 4 + 0] * rstd * gs[i * 4 + 0] + sv[i * 4 + 0], xv[i * 4 + 1] * rstd * gs[i * 4 + 1] + sv[i * 4 + 1],
                                                      xv[i * 4 + 2] * rstd * gs[i * 4 + 2] + sv[i * 4 + 2], xv[i * 4 + 3] * rstd * gs[i * 4 + 3] + sv[i * 4 + 3]);
}
DEVINL void norm_store_row(u16* Hrow, unsigned char* H8row, int lane, const float (&xv)[16], const float (&gs)[16], const float (&sv)[16]) {
    float ss = 0.f;
#pragma unroll
    for (int i = 0; i < 16; ++i) ss += xv[i] * xv[i];
    ss = wsum(ss);
    const float rstd = rsqrtf(ss * (1.f / 1024.f) + EPS);
#pragma unroll
    for (int i = 0; i < 4; ++i) {
        const float v0 = xv[i * 4 + 0] * rstd * gs[i * 4 + 0] + sv[i * 4 + 0], v1 = xv[i * 4 + 1] * rstd * gs[i * 4 + 1] + sv[i * 4 + 1];
        const float v2 = xv[i * 4 + 2] * rstd * gs[i * 4 + 2] + sv[i * 4 + 2], v3 = xv[i * 4 + 3] * rstd * gs[i * 4 + 3] + sv[i * 4 + 3];
        u32x2 o = {pk2(v0, v1), pk2(v2, v3)};
        *(u32x2*)(Hrow + i * 256 + lane * 4) = o;
        *(unsigned*)(H8row + i * 256 + lane * 4) = pk4_f8(lo2f(o[0]), hi2f(o[0]), lo2f(o[1]), hi2f(o[1]));
    }
}

DEVINL void ph_norm(const Params& p, int l, const float* xin, const float* g, int sh_off, int sc_off) {
    const int lane = TID() & 63, gw = blockIdx.x * 8 + (TID() >> 6), GW = gridDim.x * 8;
    const float* mod = (const float*)(WSP(p) + WS_MOD) + (size_t)l * 16 * 6144;
    u16* H = (u16*)(WSP(p) + WS_H);
    unsigned char* H8 = H8P(p);
    for (int t0 = gw * 32; t0 < T_; t0 += GW * 32) {
        float gs[16], sv[16];
        norm_consts(g, mod + sh_off, mod + sc_off, t0 >> 12, lane, gs, sv);
#pragma unroll 1
        for (int r = 0; r < 32; r += 2) {
            float xa[16], xb[16];
#pragma unroll
            for (int i = 0; i < 4; ++i) {
                const float4 v = *(const float4*)(xin + (size_t)(t0 + r) * 1024 + i * 256 + lane * 4), w = *(const float4*)(xin + (size_t)(t0 + r + 1) * 1024 + i * 256 + lane * 4);
                xa[i * 4] = v.x; xa[i * 4 + 1] = v.y; xa[i * 4 + 2] = v.z; xa[i * 4 + 3] = v.w; xb[i * 4] = w.x; xb[i * 4 + 1] = w.y; xb[i * 4 + 2] = w.z; xb[i * 4 + 3] = w.w;
            }
            norm_store_row(H + (size_t)(t0 + r) * 1024, H8 + (size_t)(t0 + r) * 1024, lane, xa, gs, sv);
            norm_store_row(H + (size_t)(t0 + r + 1) * 1024, H8 + (size_t)(t0 + r + 1) * 1024, lane, xb, gs, sv);
        }
    }
}

constexpr int RT_WH = 0, RT_WL = 49152, RT_CJ = 98304, RT_CNT = 98304 + 256;
DEVINL int rt_col(int r) { const int s_ = r >> 4, g_ = (r >> 2) & 3, j_ = r & 3; return s_ == 2 ? j_ : 4 + g_ * 8 + s_ * 4 + j_; }
DEVINL void ph_rtab(const Params& p) {
    unsigned char* ws = WSP(p);
    const int tid = TID(), lane = tid & 63, gw = blockIdx.x * 8 + (tid >> 6), GW = gridDim.x * 8;
    for (int idx = blockIdx.x * NTHR + tid; idx < 2 * 16 * 48 * 1024; idx += gridDim.x * NTHR) {
        const int lb = idx / (48 * 1024), rem = idx - lb * (48 * 1024), k = rem / 48, r = rem - k * 48, l = lb >> 4, b = lb & 15, col = rt_col(r);
        const float* mod = (const float*)(ws + WS_MOD) + (size_t)l * 16 * 6144 + b * 6144;
        const float wsrc = (col < 4) ? p.in[I_RGW][(size_t)l * 1024 * 4 + k * 4 + col] : p.in[I_REW][(size_t)l * 1024 * 32 + k * 32 + (col - 4)];
        const float w = p.in[I_N2G][l * 1024 + k] * (1.f + mod[4 * 1024 + k]) * wsrc;
        const u16 hi = (u16)(pk2(w, 0.f) & 0xFFFFu);
        const u16 lo = (u16)(pk2(w - bf2f(hi), 0.f) & 0xFFFFu);
        const int hf = k >> 9, kk = k & 511;
        unsigned char* img = ws + WS_RTAB + (size_t)(lb * 2 + hf) * 98304;
        const int off = r * 1024 + (((kk >> 3) ^ (r & 15)) * 16) + (kk & 7) * 2;
        *(u16*)(img + off) = hi; *(u16*)(img + 49152 + off) = lo;
    }
    for (int it = gw; it < 2 * 16 * 48; it += GW) {
        const int lb = it / 48, r = it - lb * 48, l = lb >> 4, b = lb & 15, col = rt_col(r);
        const float* sh = (const float*)(ws + WS_MOD) + (size_t)l * 16 * 6144 + b * 6144 + 3 * 1024;
        float a_ = 0.f;
        for (int k = lane; k < 1024; k += 64) a_ += sh[k] * ((col < 4) ? p.in[I_RGW][(size_t)l * 1024 * 4 + k * 4 + col] : p.in[I_REW][(size_t)l * 1024 * 32 + k * 32 + (col - 4)]);
        a_ = wsum(a_);
        if (lane == 0) ((float*)(ws + WS_RCJ))[it] = a_ + ((col < 4) ? p.in[I_RGB][l * 4 + col] : p.in[I_REB][l * 32 + (col - 4)]);
    }
}
DEVINL void ph_norm_route(const Params& p, int l, LAS unsigned char* lds) {
    unsigned char* ws = WSP(p);
    const int tid = TID(), lane = tid & 63, wave = __builtin_amdgcn_readfirstlane(tid >> 6), fr = lane & 15, fq = lane >> 4;
    const u16* x = (const u16*)(ws + WS_XM);
    const float* g2 = p.in[I_N2G] + (size_t)l * 1024;
    const float* mod = (const float*)(ws + WS_MOD) + (size_t)l * 16 * 6144;
    const float* wg = p.in[I_RGW] + (size_t)l * 1024 * 4;
    const float* we = p.in[I_REW] + (size_t)l * 1024 * 32;
    LAS float* cj = (LAS float*)(lds + RT_CJ);
    LAS unsigned* lcnt = (LAS unsigned*)(lds + RT_CNT);
    for (int blk = blockIdx.x; blk < 256; blk += gridDim.x) {
        const int b = blk >> 4;
        const float* sh = mod + b * 6144 + 3 * 1024; const float* sc = mod + b * 6144 + 4 * 1024;
        f32x4 acc[3][2];
#pragma unroll
        for (int s_ = 0; s_ < 3; ++s_) { acc[s_][0] = f32x4{0.f, 0.f, 0.f, 0.f}; acc[s_][1] = f32x4{0.f, 0.f, 0.f, 0.f}; }
        float ssq[2] = {0.f, 0.f};
        const u16* xr0 = x + (size_t)(blk * 256 + wave * 32 + fr) * 1024 + fq * 8;
#pragma unroll 1
        for (int hf = 0; hf < 2; ++hf) {
            {
                const u32x4* img = (const u32x4*)(ws + WS_RTAB + (size_t)((l * 16 + b) * 2 + hf) * 98304);
                u32x4 tv[12];
#pragma unroll
                for (int q = 0; q < 12; ++q) tv[q] = img[q * NTHR + tid];
#pragma unroll
                for (int q = 0; q < 12; ++q) *(LAS u32x4*)(lds + RT_WH + (q * NTHR + tid) * 16) = tv[q];
            }
            if (hf == 0) {
                if (tid < 32) lcnt[tid] = 0u;
                if (tid < 48) cj[tid] = ((const float*)(ws + WS_RCJ))[(l * 16 + b) * 48 + tid];
            }
            __syncthreads();
            const u16* xk = xr0 + hf * 512;
#pragma unroll 1
            for (int kg = 0; kg < 2; ++kg) {
                u32x4 xv[8][2];
#pragma unroll
                for (int q = 0; q < 8; ++q)
#pragma unroll
                    for (int ts = 0; ts < 2; ++ts) xv[q][ts] = *(const u32x4*)(xk + (kg * 8 + q) * 32 + ts * 16 * 1024);
#pragma unroll
                for (int q = 0; q < 8; ++q) {
                    const int ks = kg * 8 + q;
                    bf16x8 xh[2];
#pragma unroll
                    for (int ts = 0; ts < 2; ++ts) {
#pragma unroll
                        for (int e = 0; e < 4; ++e) { const float a_ = lo2f(xv[q][ts][e]), b_ = hi2f(xv[q][ts][e]); ssq[ts] += a_ * a_ + b_ * b_; }
                        xh[ts] = *reinterpret_cast<bf16x8*>(&xv[q][ts]);
                    }
#pragma unroll
                    for (int s_ = 0; s_ < 3; ++s_) {
                        const int off = (s_ * 16 + fr) * 1024 + (((ks * 4 + fq) ^ fr) * 16);
                        const bf16x8 wh = *(const LAS bf16x8*)(lds + RT_WH + off), wl = *(const LAS bf16x8*)(lds + RT_WL + off);
#pragma unroll
                        for (int ts = 0; ts < 2; ++ts) {
                            acc[s_][ts] = __builtin_amdgcn_mfma_f32_16x16x32_bf16(wh, xh[ts], acc[s_][ts], 0, 0, 0);
                            acc[s_][ts] = __builtin_amdgcn_mfma_f32_16x16x32_bf16(wl, xh[ts], acc[s_][ts], 0, 0, 0);
                        }
                    }
                }
            }
            __syncthreads();
        }
        int e1[2], e2[2]; unsigned r1[2] = {0u, 0u}, r2[2] = {0u, 0u}; float w1[2], w2[2]; bool mine[2];
#pragma unroll
        for (int ts = 0; ts < 2; ++ts) {
            float sst = ssq[ts]; sst += __shfl_xor(sst, 16); sst += __shfl_xor(sst, 32);
            const float rstd = rsqrtf(sst * (1.f / 1024.f) + EPS);
            const float l0 = acc[2][ts][0] * rstd + cj[32 + fq * 4 + 0], l1 = acc[2][ts][1] * rstd + cj[32 + fq * 4 + 1];
            const float l2 = acc[2][ts][2] * rstd + cj[32 + fq * 4 + 2], l3 = acc[2][ts][3] * rstd + cj[32 + fq * 4 + 3];
            int gi = 0; float gm = l0;
            if (l1 > gm) { gm = l1; gi = 1; }
            if (l2 > gm) { gm = l2; gi = 2; }
            if (l3 > gm) { gm = l3; gi = 3; }
            const float gs = __expf(l0 - gm) + __expf(l1 - gm) + __expf(l2 - gm) + __expf(l3 - gm);
            const float gw = 1.f / gs;
            float el[8];
#pragma unroll
            for (int j = 0; j < 4; ++j) { el[j] = acc[0][ts][j] * rstd + cj[fq * 4 + j]; el[4 + j] = acc[1][ts][j] * rstd + cj[16 + fq * 4 + j]; }
            int i1 = 0; float m1 = el[0];
#pragma unroll
            for (int i = 1; i < 8; ++i) if (el[i] > m1) { m1 = el[i]; i1 = i; }
            int i2 = -1; float m2 = -3.0e38f;
#pragma unroll
            for (int i = 0; i < 8; ++i) if (i != i1 && el[i] > m2) { m2 = el[i]; i2 = i; }
            const float ex = __expf(m2 - m1);
            const float p1 = 1.f / (1.f + ex), p2 = ex / (1.f + ex);
            mine[ts] = (fq == gi);
            e1[ts] = gi * 8 + i1; e2[ts] = gi * 8 + i2; w1[ts] = gw * p1; w2[ts] = gw * p2;
            if (mine[ts]) {
                r1[ts] = __hip_atomic_fetch_add(&lcnt[e1[ts]], 1u, __ATOMIC_RELAXED, __HIP_MEMORY_SCOPE_WORKGROUP);
                r2[ts] = __hip_atomic_fetch_add(&lcnt[e2[ts]], 1u, __ATOMIC_RELAXED, __HIP_MEMORY_SCOPE_WORKGROUP);
            }
        }
        __syncthreads();
        if (tid < 32) { const unsigned c = lcnt[tid]; lcnt[32 + tid] = c ? atomicAdd((unsigned*)(ws + WS_CTL) + CW_CNT + l * 32 + tid, c) : 0u; }
        __syncthreads();
#pragma unroll
        for (int ts = 0; ts < 2; ++ts) {
            if (mine[ts]) {
                const int t = blk * 256 + wave * 32 + ts * 16 + fr;
                int4* rt = (int4*)(ws + WS_ROUTE) + (size_t)t * 2;
                rt[0] = make_int4(e1[ts], (int)(lcnt[32 + e1[ts]] + r1[ts]), __float_as_int(w1[ts]), 0);
                rt[1] = make_int4(e2[ts], (int)(lcnt[32 + e2[ts]] + r2[ts]), __float_as_int(w2[ts]), 0);
            }
        }
        {
            float gs[16], sv[16];
            norm_consts(g2, mod + 3 * 1024, mod + 4 * 1024, b, lane, gs, sv);
            unsigned char* H = ws + WS_H;
#pragma unroll 1
            for (int r = 0; r < 32; r += 4) {
                const int t = blk * 256 + wave * 32 + r;
                float xq[4][16];
#pragma unroll
                for (int q = 0; q < 4; ++q)
#pragma unroll
                    for (int i = 0; i < 4; ++i) { const u32x2 v = *(const u32x2*)(x + (size_t)(t + q) * 1024 + i * 256 + lane * 4); xq[q][i * 4] = lo2f(v[0]); xq[q][i * 4 + 1] = hi2f(v[0]); xq[q][i * 4 + 2] = lo2f(v[1]); xq[q][i * 4 + 3] = hi2f(v[1]); }
#pragma unroll
                for (int q = 0; q < 4; ++q) norm_store_row_f8(H + (size_t)(t + q) * 1024, lane, xq[q], gs, sv);
            }
        }
        __syncthreads();
    }
}

constexpr bool G_SP2 = true, G_ALIGN = true;
constexpr int G_HTB = 128 * 64 * 2, G_STAGE_BYTES = 8 * G_HTB;
constexpr int LDS_POFF = G_STAGE_BYTES;
DEVINL int g_lds_byte(int r, int c) { const int st = (r >> 4) * 2 + (c >> 5), rr = r & 15, cc = c & 31, ob = rr * 64 + cc * 2; return st * 1024 + (ob ^ (((ob >> 9) & 1) << 5)); }
DEVINL void g_stage_rc(int b, int& R, int& C) { const int st = b / 1024, sb = b % 1024, swz = sb ^ (((sb >> 9) & 1) << 5); R = (st >> 1) * 16 + swz / 64; C = (st & 1) * 32 + (swz % 64) / 2; }
struct GUnit { const char* a; const char* b; int pm, pn, sub; };
DEVINL void g_tile_order(int L, int nM, int nN, int& pm, int& pn) {
    const int nwg = nM * nN; int wgid = L;
    { const int q = nwg / 8, r = nwg % 8, xcd = wgid % 8, off = wgid / 8; wgid = (xcd < r ? xcd * (q + 1) : r * (q + 1) + (xcd - r) * q) + off; }
    const int nig = 8 * nN, gid = wgid / nig, fm = gid * 8, gsz = (nM - fm) < 8 ? (nM - fm) : 8;
    pm = fm + ((wgid % nig) % gsz); pn = (wgid % nig) / gsz;
}
struct DenseSched {
    const char* A; const char* B; int lda, ldb, nM, nN; unsigned long long pnmap;
    DEVINL bool next(int i, GUnit& u) const {
        const int L = i * (int)gridDim.x + BID(); if (L >= nM * nN) return false;
        g_tile_order(L, nM, nN, u.pm, u.pn); u.sub = 0;
        if (pnmap) u.pn = (int)((pnmap >> (4 * u.pn)) & 15ull);
        u.a = A + (size_t)u.pm * 256 * lda * 2; u.b = B + (size_t)u.pn * 256 * ldb * 2; return true;
    }
};
struct SplitSched {
    const char* A; const char* A2; const char* B; int lda, ldb, nM, nN, pm_split;
    DEVINL bool next(int i, GUnit& u) const {
        const int L = i * (int)gridDim.x + BID(); if (L >= nM * nN) return false;
        g_tile_order(L, nM, nN, u.pm, u.pn); u.sub = 0;
        u.a = (u.pm < pm_split ? A + (size_t)u.pm * 256 * lda * 2 : A2 + (size_t)(u.pm - pm_split) * 256 * lda * 2); u.b = B + (size_t)u.pn * 256 * ldb * 2; return true;
    }
};
struct MoeSched {
    const char* A; const char* B; int lda, ldb; size_t bstride; LAS const int* poff;
    DEVINL bool next(int i, GUnit& u) const {
        const int L = i * (int)gridDim.x + BID(); const int ntm = __builtin_amdgcn_readfirstlane(poff[32]) >> 8; if (L >= ntm * 4) return false;
        u.pm = L >> 2; u.pn = L & 3; const int m0 = u.pm << 8; int e = 0;
        for (int q = 1; q < 32; ++q) { const int pq = __builtin_amdgcn_readfirstlane(poff[q]); if (m0 >= pq) e = q; }
        u.sub = e; u.a = A + (size_t)u.pm * 256 * lda * 2; u.b = B + (size_t)e * bstride + (size_t)u.pn * 256 * ldb * 2; return true;
    }
};
struct MoeGatherSched {
    const char* A; const char* B; int ldb; size_t bstride; LAS const int* poff; const int* tokl;
    DEVINL int tok(int row) const { return tokl[row]; }
    DEVINL bool next(int i, GUnit& u) const {
        const int L = i * (int)gridDim.x + BID(); const int ntm = __builtin_amdgcn_readfirstlane(poff[32]) >> 8; if (L >= ntm * 4) return false;
        u.pm = L >> 2; u.pn = L & 3; const int m0 = u.pm << 8; int e = 0;
        for (int q = 1; q < 32; ++q) { const int pq = __builtin_amdgcn_readfirstlane(poff[q]); if (m0 >= pq) e = q; }
        u.sub = e; u.a = A; u.b = B + (size_t)e * bstride + (size_t)u.pn * 256 * ldb * 2; return true;
    }
};
struct BranchSched {
    const char* Y0; const char* Y1; const char* Y2; const char* B;
    DEVINL bool next(int i, GUnit& u) const {
        const int tile = (i / 3) * (int)gridDim.x + BID(); if (tile >= 1024) return false;
        u.sub = i % 3; g_tile_order(tile, 256, 4, u.pm, u.pn);
        const char* y = u.sub == 0 ? Y0 : (u.sub == 1 ? Y1 : Y2);
        u.a = y + (size_t)u.pm * 256 * 512 * 2; u.b = B + (size_t)u.sub * 1024 * 512 * 2 + (size_t)u.pn * 256 * 512 * 2; return true;
    }
};

template <bool TR, bool GATHER, bool SP2, bool ALIGN, bool F8, class Sched, class Epi>
DEVINL void gemm_phase_t(LAS unsigned char* lds, const Sched& S, const Epi& E, int lda, int ldb, int K) {
    const int tid = TID(), wid = __builtin_amdgcn_readfirstlane(tid >> 6), lane = tid & 63, wr = wid >> 2, wc = wid & 3, fr = lane & 15, fq = lane >> 4;
    const int nt = K / 64;
    unsigned voffA[2], voffB[2];
#pragma unroll
    for (int i = 0; i < 2; ++i) { int R, C; g_stage_rc(tid * 16 + i * 8192, R, C);
        const int Ra = TR ? ((R & ~31) + 8 * ((R & 15) >> 2) + 4 * ((R >> 4) & 1) + (R & 3)) : R;
        voffA[i] = (unsigned)(Ra * lda + C) * 2u; voffB[i] = (unsigned)(R * ldb + C) * 2u; }
    const size_t kstep = 128, hstepA = GATHER ? 0 : (size_t)128 * lda * 2, hstepB = (size_t)128 * ldb * 2;
    unsigned gA[2][2] = {{0u, 0u}, {0u, 0u}}, gN[2][2] = {{0u, 0u}, {0u, 0u}};
#define PG8_TOK(dst, un) do { if constexpr (GATHER) { _Pragma("unroll") for (int h_ = 0; h_ < 2; ++h_) _Pragma("unroll") for (int i_ = 0; i_ < 2; ++i_) { int R_, C_; g_stage_rc(tid * 16 + i_ * 8192, R_, C_); \
        dst[h_][i_] = ((unsigned)S.tok((un).pm * 256 + h_ * 128 + R_) * (unsigned)lda + (unsigned)C_) * 2u; } } } while (0)
#define VA0(nx) (GATHER ? ((nx) ? gN[0] : gA[0]) : voffA)
#define VA1(nx) (GATHER ? ((nx) ? gN[1] : gA[1]) : voffA)
    const unsigned ldsw = (unsigned)wid * 1024u;
    const int aoff = g_lds_byte(wr * 64 + fr, fq * 8), boff = g_lds_byte(wc * 32 + fr, fq * 8);
#define PG8_SA(b, h) (((b) * 2 + (h)) * G_HTB)
#define PG8_SB(b, h) ((4 + (b) * 2 + (h)) * G_HTB)
#define PG8_STAGE(bufoff, gbase, voff) do { _Pragma("unroll") for (int _i = 0; _i < 2; ++_i) \
        __builtin_amdgcn_global_load_lds((const unsigned*)((const char*)(gbase) + (voff)[_i]), (LAS unsigned*)(lds + (bufoff) + ldsw + _i * 8192), 16, 0, 0); } while (0)
#define PG8_LDA(dst, b, h) do { if constexpr (F8) { _Pragma("unroll") for (int m = 0; m < 4; ++m) { const v4i lo_ = *(const LAS v4i*)(lds + PG8_SA(b, h) + aoff + m * 2048), hi_ = *(const LAS v4i*)(lds + PG8_SA(b, h) + aoff + m * 2048 + 1024); \
        dst##8[m] = __builtin_shufflevector(lo_, hi_, 0, 1, 2, 3, 4, 5, 6, 7); } } else { _Pragma("unroll") for (int m = 0; m < 4; ++m) _Pragma("unroll") for (int k = 0; k < 2; ++k) dst[m][k] = *(const LAS bf16x8*)(lds + PG8_SA(b, h) + aoff + m * 2048 + k * 1024); } } while (0)
#define PG8_LDB(dst, b, h) do { if constexpr (F8) { _Pragma("unroll") for (int n = 0; n < 2; ++n) { const v4i lo_ = *(const LAS v4i*)(lds + PG8_SB(b, h) + boff + n * 2048), hi_ = *(const LAS v4i*)(lds + PG8_SB(b, h) + boff + n * 2048 + 1024); \
        dst##8[n] = __builtin_shufflevector(lo_, hi_, 0, 1, 2, 3, 4, 5, 6, 7); } } else { _Pragma("unroll") for (int n = 0; n < 2; ++n) _Pragma("unroll") for (int k = 0; k < 2; ++k) dst[n][k] = *(const LAS bf16x8*)(lds + PG8_SB(b, h) + boff + n * 2048 + k * 1024); } } while (0)
#define PG8_MMA(ai, bj, At, Bt) do { __builtin_amdgcn_s_setprio(1); if constexpr (F8) { _Pragma("unroll") for (int m = 0; m < 4; ++m) _Pragma("unroll") for (int n = 0; n < 2; ++n) \
        asm volatile("v_mfma_f32_16x16x128_f8f6f4 %0, %1, %2, %0" : "+v"(acc[ai][bj][m][n]) : "v"(Bt##8[n]), "v"(At##8[m])); } else \
        _Pragma("unroll") for (int m = 0; m < 4; ++m) _Pragma("unroll") for (int n = 0; n < 2; ++n) _Pragma("unroll") for (int k = 0; k < 2; ++k) \
        acc[ai][bj][m][n] = TR ? __builtin_amdgcn_mfma_f32_16x16x32_bf16(At[m][k], Bt[n][k], acc[ai][bj][m][n], 0, 0, 0) : __builtin_amdgcn_mfma_f32_16x16x32_bf16(Bt[n][k], At[m][k], acc[ai][bj][m][n], 0, 0, 0); __builtin_amdgcn_s_setprio(0); } while (0)
#define PG8_WAIT_V(n) asm volatile("s_waitcnt vmcnt(" #n ")" ::: "memory")
#define PG8_WAIT_L(n) asm volatile("s_waitcnt lgkmcnt(" #n ")" ::: "memory")
#define PG8_BAR __builtin_amdgcn_s_barrier()
#define PG8_SCHED __builtin_amdgcn_sched_barrier(0)
    GUnit cur, nxt; int ui = 0;
    if (!S.next(0, cur)) return;
    f32x4 acc[2][2][4][2];
#pragma unroll
    for (int a = 0; a < 2; ++a)
#pragma unroll
        for (int b = 0; b < 2; ++b)
#pragma unroll
            for (int m = 0; m < 4; ++m)
#pragma unroll
                for (int n = 0; n < 2; ++n) acc[a][b][m][n] = (f32x4){0.f, 0.f, 0.f, 0.f};
    bf16x8 At[4][2], B0[2][2], B1[2][2];
    v8i At8[4], B08[2], B18[2];
    const char* cA = cur.a; const char* cB = cur.b;
    PG8_TOK(gA, cur);
    if constexpr (SP2) {
        PG8_STAGE(PG8_SB(0, 0), cB, voffB); PG8_STAGE(PG8_SB(0, 1), cB + hstepB, voffB); PG8_STAGE(PG8_SA(0, 0), cA, VA0(false)); PG8_STAGE(PG8_SA(0, 1), cA + hstepA, VA1(false));
        if (wr == 1) PG8_BAR;
        PG8_WAIT_V(2); PG8_BAR;
        PG8_STAGE(PG8_SB(1, 0), cB + kstep, voffB); PG8_STAGE(PG8_SA(1, 0), cA + kstep, VA0(false)); PG8_STAGE(PG8_SB(1, 1), cB + hstepB + kstep, voffB);
        PG8_WAIT_V(6); PG8_BAR;
    } else {
    PG8_STAGE(PG8_SB(0, 0), cB, voffB); PG8_STAGE(PG8_SA(0, 0), cA, VA0(false)); PG8_STAGE(PG8_SB(0, 1), cB + hstepB, voffB); PG8_STAGE(PG8_SA(0, 1), cA + hstepA, VA1(false));
    if (wr == 1) PG8_BAR;
    PG8_WAIT_V(4); PG8_BAR;
    PG8_STAGE(PG8_SB(1, 0), cB + kstep, voffB); PG8_STAGE(PG8_SA(1, 0), cA + kstep, VA0(false)); PG8_STAGE(PG8_SB(1, 1), cB + hstepB + kstep, voffB);
    PG8_WAIT_V(6); PG8_BAR;
    }
    for (;;) {
        const bool has_next = S.next(ui + 1, nxt);
        const char* nA = has_next ? nxt.a : cA; const char* nB = has_next ? nxt.b : cB;
        if (GATHER) { if (has_next) PG8_TOK(gN, nxt); else { gN[0][0] = gA[0][0]; gN[0][1] = gA[0][1]; gN[1][0] = gA[1][0]; gN[1][1] = gA[1][1]; } }
#pragma unroll 1
        for (int t = 0; t < nt; t += 2) {
            const bool last = (t == nt - 2);
            const char* a1 = cA + (size_t)(t + 1) * kstep;
            const char* a2 = last ? nA : cA + (size_t)(t + 2) * kstep; const char* b2 = last ? nB : cB + (size_t)(t + 2) * kstep;
            const char* a3 = a2 + kstep; const char* b3 = b2 + kstep;
            if constexpr (SP2) {
            PG8_LDB(B0, 0, 0); PG8_LDB(B1, 0, 1); PG8_SCHED; PG8_LDA(At, 0, 0); PG8_STAGE(PG8_SA(1, 1), a1 + hstepA, VA1(false));
            PG8_WAIT_V(8); PG8_WAIT_L(0); PG8_BAR; PG8_MMA(0, 0, At, B0); PG8_MMA(0, 1, At, B1); PG8_BAR; PG8_SCHED;
            PG8_LDA(At, 0, 1); PG8_STAGE(PG8_SB(0, 0), b2, voffB); PG8_STAGE(PG8_SB(0, 1), b2 + hstepB, voffB); PG8_STAGE(PG8_SA(0, 0), a2, VA0(last));
            PG8_WAIT_V(8); PG8_WAIT_L(0); PG8_BAR; PG8_MMA(1, 0, At, B0); PG8_MMA(1, 1, At, B1); PG8_BAR; PG8_SCHED;
            PG8_LDB(B0, 1, 0); PG8_LDB(B1, 1, 1); PG8_SCHED; PG8_LDA(At, 1, 0); PG8_STAGE(PG8_SA(0, 1), a2 + hstepA, VA1(last));
            PG8_WAIT_V(8); PG8_WAIT_L(0); PG8_BAR; PG8_MMA(0, 0, At, B0); PG8_MMA(0, 1, At, B1); PG8_BAR; PG8_SCHED;
            PG8_LDA(At, 1, 1); PG8_STAGE(PG8_SB(1, 0), b3, voffB); PG8_STAGE(PG8_SB(1, 1), b3 + hstepB, voffB); PG8_STAGE(PG8_SA(1, 0), a3, VA0(last));
            PG8_WAIT_V(8); PG8_WAIT_L(0); PG8_BAR; PG8_MMA(1, 0, At, B0); PG8_MMA(1, 1, At, B1); PG8_BAR; PG8_SCHED;
            } else {
            PG8_LDB(B0, 0, 0); PG8_SCHED; PG8_LDA(At, 0, 0); PG8_STAGE(PG8_SA(1, 1), a1 + hstepA, VA1(false));
            PG8_WAIT_L(8); PG8_BAR; PG8_WAIT_L(0); PG8_MMA(0, 0, At, B0); PG8_BAR; PG8_SCHED;
            PG8_LDB(B1, 0, 1); PG8_STAGE(PG8_SB(0, 0), b2, voffB);
            PG8_BAR; PG8_WAIT_L(0); PG8_MMA(0, 1, At, B1); PG8_BAR;
            PG8_LDA(At, 0, 1); PG8_STAGE(PG8_SA(0, 0), a2, VA0(last));
            PG8_BAR; PG8_WAIT_L(0); PG8_MMA(1, 0, At, B0); PG8_BAR; PG8_SCHED;
            PG8_STAGE(PG8_SB(0, 1), b2 + hstepB, voffB);
            PG8_WAIT_V(6); PG8_BAR; PG8_MMA(1, 1, At, B1); PG8_BAR;
            PG8_LDB(B0, 1, 0); PG8_SCHED; PG8_LDA(At, 1, 0); PG8_STAGE(PG8_SA(0, 1), a2 + hstepA, VA1(last));
            PG8_WAIT_L(8); PG8_BAR; PG8_WAIT_L(0); PG8_MMA(0, 0, At, B0); PG8_BAR; PG8_SCHED;
            PG8_LDB(B1, 1, 1); PG8_STAGE(PG8_SB(1, 0), b3, voffB);
            PG8_BAR; PG8_WAIT_L(0); PG8_MMA(0, 1, At, B1); PG8_BAR;
            PG8_LDA(At, 1, 1); PG8_STAGE(PG8_SA(1, 0), a3, VA0(last));
            PG8_BAR; PG8_WAIT_L(0); PG8_MMA(1, 0, At, B0); PG8_BAR; PG8_SCHED;
            PG8_STAGE(PG8_SB(1, 1), b3 + hstepB, voffB);
            PG8_WAIT_V(6); PG8_BAR; PG8_MMA(1, 1, At, B1); PG8_BAR;
                    }
        }
        if constexpr (F8) asm volatile("s_nop 15\n\ts_nop 15" ::: "memory");
        if constexpr (ALIGN) { if (wr == 0) PG8_BAR; }
        E(acc, cur, wr, wc, fr, fq);
        if (!has_next) break;
        if (!E.keep(cur))
#pragma unroll
        for (int a = 0; a < 2; ++a)
#pragma unroll
            for (int b = 0; b < 2; ++b)
#pragma unroll
                for (int m = 0; m < 4; ++m)
#pragma unroll
                    for (int n = 0; n < 2; ++n) acc[a][b][m][n] = (f32x4){0.f, 0.f, 0.f, 0.f};
        cur = nxt; cA = nA; cB = nB; ++ui;
        if (GATHER) { gA[0][0] = gN[0][0]; gA[0][1] = gN[0][1]; gA[1][0] = gN[1][0]; gA[1][1] = gN[1][1]; }
        if constexpr (ALIGN) { if (wr == 1) PG8_BAR; }
    }
    PG8_WAIT_V(0);
    if constexpr (!ALIGN) { if (wr == 0) PG8_BAR; }
    PG8_BAR;
#undef PG8_TOK
#undef VA0
#undef VA1
#undef PG8_SA
#undef PG8_SB
#undef PG8_STAGE
#undef PG8_LDA
#undef PG8_LDB
#undef PG8_MMA
#undef PG8_WAIT_V
#undef PG8_WAIT_L
#undef PG8_BAR
#undef PG8_SCHED
}
template <class Sched, class Epi> DEVINL void gemm_phase(LAS unsigned char* lds, const Sched& S, const Epi& E, int lda, int ldb, int K) { gemm_phase_t<false, false, G_SP2, G_ALIGN, false>(lds, S, E, lda, ldb, K); }
DEVINL void st4bf(u16* dst, f32x4 v) { u32x2 o = {pk2(v[0], v[1]), pk2(v[2], v[3])}; *(u32x2*)dst = o; }
DEVINL void st8bf(u16* dst, f32x4 a, f32x4 b) { u32x4 o = {pk2(a[0], a[1]), pk2(a[2], a[3]), pk2(b[0], b[1]), pk2(b[2], b[3])}; *(u32x4*)dst = o; }
typedef f32x4 GAcc[2][2][4][2];
#define G_ROW(u, ai, m) ((u).pm * 256 + (ai) * 128 + wr * 64 + (m) * 16 + fr)
#define G_RUN(u, bj) ((u).pn * 256 + (bj) * 128 + wc * 32)

struct EpiProj {
    unsigned char* ws;
    DEVINL bool keep(const GUnit&) const { return false; }
    DEVINL void operator()(const GAcc& acc, const GUnit& u, int wr, int wc, int fr, int fq) const {
#pragma unroll
        for (int bj = 0; bj < 2; ++bj) {
            const int cb = G_RUN(u, bj);
            u16* dst; int ld, c0;
            if (cb < 512) { dst = (u16*)(ws + WS_RQK); ld = 512; c0 = cb; }
            else if (cb < 1024) { dst = (u16*)(ws + WS_RV); ld = 512; c0 = cb - 512; }
            else if (cb < 1536) { dst = (u16*)(ws + WS_RG); ld = 512; c0 = cb - 1024; }
            else if (cb < 2048) { dst = (u16*)(ws + WS_FQ); ld = 512; c0 = cb - 1536; }
            else if (cb < 2560) { dst = (u16*)(ws + WS_FK); ld = 512; c0 = cb - 2048; }
            else if (cb < 3072) { dst = (u16*)(ws + WS_FV); ld = 512; c0 = cb - 2560; }
            else if (cb < 3328) { dst = (u16*)(ws + WS_MQ); ld = 256; c0 = cb - 3072; }
            else if (cb < 3456) { dst = (u16*)(ws + WS_MKV); ld = 128; c0 = cb - 3328; }
            else if (cb < 3520) { dst = (u16*)(ws + WS_KPE); ld = 64; c0 = cb - 3456; }
            else { dst = nullptr; ld = 0; c0 = 0; }
            const bool roped = (cb < 512) || (cb >= 3456 && cb < 3520);
            if (dst && roped) {
                const int g = (cb >> 5) & 1, hb = c0 & ~63, i0 = 16 * g + 4 * fq;
                const float2* tab = (const float2*)(ws + WS_ROPE);
#pragma unroll
                for (int ai = 0; ai < 2; ++ai)
#pragma unroll
                    for (int m = 0; m < 4; ++m) {
                        int row = G_ROW(u, ai, m); asm volatile("" : "+v"(row));
                        const float4 t0 = *(const float4*)(tab + (size_t)row * 32 + i0), t1 = *(const float4*)(tab + (size_t)row * 32 + i0 + 2);
                        const f32x4 x1 = acc[ai][bj][m][0], x2 = acc[ai][bj][m][1];
                        f32x4 y1, y2;
                        y1[0] = x1[0] * t0.x - x2[0] * t0.y; y2[0] = x2[0] * t0.x + x1[0] * t0.y;
                        y1[1] = x1[1] * t0.z - x2[1] * t0.w; y2[1] = x2[1] * t0.z + x1[1] * t0.w;
                        y1[2] = x1[2] * t1.x - x2[2] * t1.y; y2[2] = x2[2] * t1.x + x1[2] * t1.y;
                        y1[3] = x1[3] * t1.z - x2[3] * t1.w; y2[3] = x2[3] * t1.z + x1[3] * t1.w;
                        u16* rp = dst + (size_t)row * ld + hb + i0;
                        st4bf(rp, y1); st4bf(rp + 32, y2);
                        asm volatile("" ::: "memory");
                    }
            } else if (dst) {
#pragma unroll
                for (int ai = 0; ai < 2; ++ai)
#pragma unroll
                    for (int m = 0; m < 4; ++m) {
                        st8bf(dst + (size_t)G_ROW(u, ai, m) * ld + c0 + fq * 8, acc[ai][bj][m][0], acc[ai][bj][m][1]);
                    }
            } else if (cb == 3520 && fq == 0) {
                float* ffl = (float*)(ws + WS_FFL);
#pragma unroll
                for (int ai = 0; ai < 2; ++ai)
#pragma unroll
                    for (int m = 0; m < 4; ++m) *(f32x4*)(ffl + (size_t)G_ROW(u, ai, m) * 4) = acc[ai][bj][m][0];
            }
        }
    }
};
struct EpiVT { u16* dst; int col0; u16* dst2; int col2; int pn_split;
    DEVINL bool keep(const GUnit&) const { return false; }
    DEVINL void operator()(const GAcc& acc, const GUnit& u, int wr, int wc, int fr, int fq) const {
        const int b = u.pm >> 4, s0 = (u.pm & 15) * 256;
        u16* d = u.pn >= pn_split ? dst2 : dst; const int c0 = u.pn >= pn_split ? col2 : col0;
#pragma unroll
        for (int bj = 0; bj < 2; ++bj)
#pragma unroll
            for (int n = 0; n < 2; ++n) {
                const int eg = u.pn * 256 + bj * 128 + wc * 32 + n * 16 + fr - c0;
                u16* rp = d + ((size_t)(b * 4 + (eg >> 7)) * 128 + (eg & 127)) * 4096 + s0 + wr * 64 + fq * 8;
#pragma unroll
                for (int ai = 0; ai < 2; ++ai)
#pragma unroll
                    for (int g = 0; g < 2; ++g) st8bf(rp + ai * 128 + g * 32, acc[ai][bj][2 * g][n], acc[ai][bj][2 * g + 1][n]);
            }
    }
};
DEVINL void ph_gemm_in(const Params& p, LAS unsigned char* lds) {
    unsigned char* ws = WSP(p);
    { DenseSched SV{(const char*)(ws + WS_H), (const char*)(ws + WS_WIN), 1024, 1024, 256, 4, 0xBA32ull};
      gemm_phase_t<true, false, G_SP2, G_ALIGN, false>(lds, SV, EpiVT{(u16*)(ws + WS_RV), 512, (u16*)(ws + WS_FV), 2560, 8}, 1024, 1024, 1024); }
    DenseSched S{(const char*)(ws + WS_H), (const char*)(ws + WS_WIN), 1024, 1024, 256, 10, 0xDC98765410ull};
    gemm_phase(lds, S, EpiProj{ws}, 1024, 1024, 1024);
}
struct EpiStore { u16* dst; int ld;
    DEVINL bool keep(const GUnit&) const { return false; }
    DEVINL void operator()(const GAcc& acc, const GUnit& u, int wr, int wc, int fr, int fq) const {
#pragma unroll
        for (int ai = 0; ai < 2; ++ai)
#pragma unroll
            for (int m = 0; m < 4; ++m)
#pragma unroll
                for (int bj = 0; bj < 2; ++bj) {
                    st8bf(dst + (size_t)G_ROW(u, ai, m) * ld + G_RUN(u, bj) + fq * 8, acc[ai][bj][m][0], acc[ai][bj][m][1]);
                }
    }
};

template <int W>
DEVINL void rmsnorm_inplace(u16* buf, const float* g) {
    const int lane = TID() & 63, gw = blockIdx.x * 8 + (TID() >> 6), GW = gridDim.x * 8;
    constexpr int PER = W / 64;
    float gl[PER];
#pragma unroll
    for (int i = 0; i < PER; ++i) gl[i] = g[lane * PER + i];
    for (int t = gw * 4; t < T_; t += GW * 4) {
        float v[4][PER];
#pragma unroll
        for (int q = 0; q < 4; ++q) {
            const u16* r = buf + (size_t)(t + q) * W + lane * PER;
            if constexpr (PER == 4) { const u32x2 w = *(const u32x2*)r; v[q][0] = lo2f(w[0]); v[q][1] = hi2f(w[0]); v[q][2] = lo2f(w[1]); v[q][3] = hi2f(w[1]); }
            else { const unsigned w = *(const unsigned*)r; v[q][0] = lo2f(w); v[q][1] = hi2f(w); }
        }
#pragma unroll
        for (int q = 0; q < 4; ++q) {
            float ss = 0.f;
#pragma unroll
            for (int i = 0; i < PER; ++i) ss += v[q][i] * v[q][i];
            ss = wsum(ss);
            const float rstd = rsqrtf(ss * (1.f / W) + EPS);
            u16* r = buf + (size_t)(t + q) * W + lane * PER;
            if constexpr (PER == 4) { const u32x2 o = {pk2(v[q][0] * rstd * gl[0], v[q][1] * rstd * gl[1]), pk2(v[q][2] * rstd * gl[2], v[q][3] * rstd * gl[3])}; *(u32x2*)r = o; }
            else *(unsigned*)r = pk2(v[q][0] * rstd * gl[0], v[q][1] * rstd * gl[1]);
        }
    }
}
DEVINL void ph_fcum(const Params& p, int l, LAS unsigned char* lds) {
    const int tid = TID(), lane = tid & 63, wave = tid >> 6;
    const float* ffl = (const float*)(WSP(p) + WS_FFL);
    float* fc = (float*)(WSP(p) + WS_FCUM);
    LAS float* wt = (LAS float*)lds;
    for (int bh = blockIdx.x; bh < 64; bh += gridDim.x) {
        const int b = bh >> 2, h = bh & 3;
        const float fb = p.in[I_FOXFB][l * 4 + h];
        float x[8], vals[8];
#pragma unroll
        for (int c = 0; c < 8; ++c) x[c] = ffl[((size_t)b * 4096 + (wave * 8 + c) * 64 + lane) * 4 + h] + fb;
        float carry = 0.f;
#pragma unroll
        for (int c = 0; c < 8; ++c) {
            float v = fminf(x[c], 0.f) - log1pf(__expf(-fabsf(x[c])));
#pragma unroll
            for (int o = 1; o < 64; o <<= 1) { const float n = __shfl_up(v, o); if (lane >= o) v += n; }
            vals[c] = carry + v;
            carry += __shfl(v, 63);
        }
        __syncthreads();
        if (lane == 0) wt[wave] = carry;
        __syncthreads();
        float off = 0.f;
        for (int w2 = 0; w2 < wave; ++w2) off += wt[w2];
#pragma unroll
        for (int c = 0; c < 8; ++c) fc[(size_t)bh * 4096 + (wave * 8 + c) * 64 + lane] = off + vals[c];
    }
}

DEVINL void retention_unit(const Params& p, LAS unsigned char* lds, const int bh) {
    unsigned char* ws = WSP(p);
    const int tid = TID(), lane = tid & 63, wave = __builtin_amdgcn_readfirstlane(tid >> 6), fr_ = lane & 15, fq_ = lane >> 4;
    constexpr int KIMG = 0, KTIMG = 16384, VTIMG = 32768, STIMG = 65536;
    const u16* RQK = (const u16*)(ws + WS_RQK); const u16* RVT = (const u16*)(ws + WS_RVT); u16* RG = (u16*)(ws + WS_RG);
    const int st_ = tid >> 2;
    const int skc = (tid & 3) * 2, svc = (tid & 3) * 4;
    const int qloc = wave * 16 + fr_;
    const int ncc = (wave >> 1) + 1;
    {
        const int b = bh >> 2, h = bh & 3;
        const float lg = (h == 0) ? -0.04580368961312479f : (h == 1) ? -0.02272007650008353f : (h == 2) ? -0.011315313227834146f : -0.005646563141142063f;
        const float g128 = __builtin_amdgcn_exp2f(128.f * lg);
        const float kfac = __builtin_amdgcn_exp2f((float)(127 - st_) * lg) * 0.125f;
        const float qdec = __builtin_amdgcn_exp2f((float)(qloc + 1) * lg);
        f32x4 S[4];
#pragma unroll
        for (int dt = 0; dt < 4; ++dt) S[dt] = f32x4{0.f, 0.f, 0.f, 0.f};
        for (int i = tid; i < 16384 / 16; i += NTHR) *(LAS u32x4*)(lds + STIMG + i * 16) = u32x4{0u, 0u, 0u, 0u};
        const size_t seq0 = (size_t)b * 4096;
        bf16x8 kreg[2], vreg[4], qf[2];
#define RET_LOAD(n_) do { const size_t r_ = seq0 + (size_t)(n_) * 128; \
            _Pragma("unroll") for (int i = 0; i < 2; ++i) kreg[i] = *(const bf16x8*)(RQK + (r_ + st_) * 512 + 256 + h * 64 + (skc + i) * 8); \
            _Pragma("unroll") for (int i = 0; i < 4; ++i) vreg[i] = *(const bf16x8*)(RVT + ((size_t)bh * 128 + st_) * 4096 + (size_t)(n_) * 128 + (svc + i) * 8); \
            _Pragma("unroll") for (int dc = 0; dc < 2; ++dc) qf[dc] = *(const bf16x8*)(RQK + (r_ + qloc) * 512 + h * 64 + dc * 32 + fq_ * 8); } while (0)
        RET_LOAD(0);
        for (int n = 0; n < 32; ++n) {
            const size_t row0 = seq0 + (size_t)n * 128;
            int st = st_, fr = fr_, fq = fq_;
            asm volatile("" : "+v"(st), "+v"(fr), "+v"(fq));
            const int lb0 = fr * 256 + ((fq ^ (fr & 3)) * 16);
            const int sb0 = fr * 128 + ((fq ^ ((fr >> 1) & 3)) * 16);
            const int kb0 = ((fr >> 2) * 8 + (fr & 3)) * 128 + ((fq ^ ((fr >> 1) & 3)) * 16);
            const int swzp = ((st >> 1) & 1) | (((st >> 3) & 3) << 1);
#pragma unroll
            for (int i = 0; i < 2; ++i) {
                const int c = skc + i;
                *(LAS bf16x8*)(lds + KIMG + st * 128 + ((c ^ swzp) * 16)) = kreg[i];
#pragma unroll
                for (int j = 0; j < 8; ++j) {
                    const int d = c * 8 + j;
                    *(LAS u16*)(lds + KTIMG + d * 256 + (((st >> 3) ^ (d & 15)) * 16) + (st & 7) * 2) = f2bf(kfac * bf2f((u16)kreg[i][j]));
                }
            }
#pragma unroll
            for (int i = 0; i < 4; ++i) {
                const int c = svc + i;
                *(LAS bf16x8*)(lds + VTIMG + st * 256 + ((c ^ (st & 15)) * 16)) = vreg[i];
            }
            const bf16x8 q0 = qf[0], q1 = qf[1];
            __syncthreads();
            if (n < 31) RET_LOAD(n + 1);
            bf16x8 pf[4];
#pragma unroll
            for (int cc = 0; cc < 4; ++cc) {
                if (cc < ncc) {
                    f32x4 s0 = f32x4{0.f, 0.f, 0.f, 0.f}, s1 = s0;
#pragma unroll
                    for (int dc = 0; dc < 2; ++dc) {
                        const int ka = kb0 + ((dc ^ (fr >> 3)) * 64);
                        const bf16x8 k0 = *(const LAS bf16x8*)(lds + ka + (KIMG + cc * 4096));
                        const bf16x8 k1 = *(const LAS bf16x8*)(lds + ka + (KIMG + cc * 4096 + 512));
                        s0 = __builtin_amdgcn_mfma_f32_16x16x32_bf16(k0, dc ? q1 : q0, s0, 0, 0, 0);
                        s1 = __builtin_amdgcn_mfma_f32_16x16x32_bf16(k1, dc ? q1 : q0, s1, 0, 0, 0);
                    }
                    float pv[8];
#pragma unroll
                    for (int jj = 0; jj < 4; ++jj) {
                        const int m0 = cc * 32 + fq * 8 + jj, m1 = m0 + 4;
                        pv[jj] = (m0 <= qloc) ? s0[jj] * 0.125f * __builtin_amdgcn_exp2f((float)(qloc - m0) * lg) : 0.f;
                        pv[4 + jj] = (m1 <= qloc) ? s1[jj] * 0.125f * __builtin_amdgcn_exp2f((float)(qloc - m1) * lg) : 0.f;
                    }
                    u32x4 w = {pk2(pv[0], pv[1]), pk2(pv[2], pv[3]), pk2(pv[4], pv[5]), pk2(pv[6], pv[7])};
                    pf[cc] = *reinterpret_cast<bf16x8*>(&w);
                }
            }
            f32x4 o[8];
#pragma unroll
            for (int et = 0; et < 8; ++et) {
                f32x4 a = f32x4{0.f, 0.f, 0.f, 0.f};
#pragma unroll
                for (int dc = 0; dc < 2; ++dc) {
                    const bf16x8 sf = *(const LAS bf16x8*)(lds + (sb0 + ((dc ^ (fr >> 3)) * 64)) + (STIMG + et * 2048));
                    a = __builtin_amdgcn_mfma_f32_16x16x32_bf16(sf, dc ? q1 : q0, a, 0, 0, 0);
                }
                a[0] *= qdec; a[1] *= qdec; a[2] *= qdec; a[3] *= qdec;
#pragma unroll
                for (int cc = 0; cc < 4; ++cc) {
                    if (cc < ncc) {
                        const bf16x8 vf = *(const LAS bf16x8*)(lds + (lb0 + ((cc ^ (fr >> 2)) * 64)) + (VTIMG + et * 4096));
                        a = __builtin_amdgcn_mfma_f32_16x16x32_bf16(vf, pf[cc], a, 0, 0, 0);
                    }
                }
                o[et] = a;
            }
#pragma unroll
            for (int dt = 0; dt < 4; ++dt) { S[dt][0] *= g128; S[dt][1] *= g128; S[dt][2] *= g128; S[dt][3] *= g128; }
#pragma unroll
            for (int cc = 0; cc < 4; ++cc) {
                const int la = lb0 + ((cc ^ (fr >> 2)) * 64);
                const bf16x8 vb = *(const LAS bf16x8*)(lds + la + wave * 4096 + VTIMG);
#pragma unroll
                for (int dt = 0; dt < 4; ++dt) {
                    const bf16x8 kt = *(const LAS bf16x8*)(lds + la + (KTIMG + dt * 4096));
                    S[dt] = __builtin_amdgcn_mfma_f32_16x16x32_bf16(kt, vb, S[dt], 0, 0, 0);
                }
            }
            __syncthreads();
            {
                const int e = wave * 16 + fr;
#pragma unroll
                for (int dt = 0; dt < 4; ++dt) {
                    u32x2 w = {pk2(S[dt][0], S[dt][1]), pk2(S[dt][2], S[dt][3])};
                    *(LAS u32x2*)(lds + STIMG + e * 128 + ((((dt * 2 + (fq >> 1)) ^ (e >> 1)) & 7) * 16) + (fq & 1) * 8) = w;
                }
            }
            float s1 = 0.f;
#pragma unroll
            for (int et = 0; et < 8; ++et) s1 += o[et][0] + o[et][1] + o[et][2] + o[et][3];
            s1 += __shfl_xor(s1, 16); s1 += __shfl_xor(s1, 32);
            const float mu = s1 * (1.f / 128.f);
            float s2 = 0.f;
#pragma unroll
            for (int et = 0; et < 8; ++et)
#pragma unroll
                for (int jj = 0; jj < 4; ++jj) { const float dlt = o[et][jj] - mu; s2 += dlt * dlt; }
            s2 += __shfl_xor(s2, 16); s2 += __shfl_xor(s2, 32);
            const float rs = rsqrtf(s2 * (1.f / 128.f) + EPS);
            u16* gp = RG + (row0 + qloc) * 512 + h * 128 + fq * 4;
#pragma unroll
            for (int et = 0; et < 8; ++et) {
                const u32x2 gv = *(const u32x2*)(gp + et * 16);
                f32x4 y;
                y[0] = siluf_(lo2f(gv[0])) * (o[et][0] - mu) * rs; y[1] = siluf_(hi2f(gv[0])) * (o[et][1] - mu) * rs;
                y[2] = siluf_(lo2f(gv[1])) * (o[et][2] - mu) * rs; y[3] = siluf_(hi2f(gv[1])) * (o[et][3] - mu) * rs;
                st4bf(gp + et * 16, y);
            }
        }
#undef RET_LOAD
        __syncthreads();
    }
}

DEVINL void ph_kmax(const Params& p, int l) {
    unsigned char* ws = WSP(p);
    const int lane = TID() & 63, gw = blockIdx.x * 8 + (TID() >> 6), GW = gridDim.x * 8;
    unsigned* kmax = (unsigned*)(ws + WS_CTL) + CW_KMAX + l * 64;
    for (int c = gw; c < 2048; c += GW) {
        const int bh = c >> 5, b = bh >> 2, h = bh & 3, s0 = (c & 31) * 128;
        float mx = 0.f;
#pragma unroll
        for (int q = 0; q < 2; ++q) {
            const u32x4* rp = (const u32x4*)((const u16*)(ws + WS_FK) + ((size_t)b * 4096 + s0 + q * 64 + lane) * 512 + h * 128);
            u32x4 v[16];
#pragma unroll
            for (int i = 0; i < 16; ++i) v[i] = rp[i];
            float ss = 0.f;
#pragma unroll
            for (int i = 0; i < 16; ++i)
#pragma unroll
                for (int e = 0; e < 4; ++e) { const float lo = lo2f(v[i][e]), hi = hi2f(v[i][e]); ss += lo * lo + hi * hi; }
            mx = fmaxf(mx, ss);
        }
        for (int o = 32; o; o >>= 1) mx = fmaxf(mx, __shfl_xor(mx, o));
        if (lane == 0) atomicMax(&kmax[bh], __float_as_uint(sqrtf(mx)));
    }
}

template <bool MLA>
DEVINL void attn_unit(const Params& p, LAS unsigned char* lds, int l, int bh, int qt) {
    unsigned char* ws = WSP(p);
    const int tid = TID(), lane = tid & 63, wave = __builtin_amdgcn_readfirstlane(tid >> 6), fr = lane & 15, fq = lane >> 4;
    const int b = bh >> 2, h = bh & 3, t0 = qt * 256, wrow0 = t0 + wave * 32;
    constexpr int DC = MLA ? 6 : 4;
    constexpr float L2E = 1.4426950408889634f;
    constexpr float C2 = (MLA ? 0.07216878364870323f : 0.08838834764831845f) * L2E;
    constexpr int BUF = 40960, VOTE_OFF = 122880;
    const size_t rowb = (size_t)b * 4096;
    const u16* Kg = (const u16*)(ws + (MLA ? WS_KN : WS_FK)) + rowb * 512 + h * 128;
    const int kld = 512;
    const u16* KPg = (const u16*)(ws + WS_KPE) + rowb * 64;
    const u16* VTg = (const u16*)(ws + (MLA ? WS_MVT : WS_FVT)) + (size_t)bh * 128 * 4096;
    u16* Qg = MLA ? (u16*)(ws + WS_Q) + (rowb + wrow0) * 768 + h * 192 : (u16*)(ws + WS_FQ) + (rowb + wrow0) * 512 + h * 128;
    const int qld = MLA ? 768 : 512;
    u16* Og = MLA ? (u16*)(ws + WS_YC) + (rowb + wrow0) * 512 + h * 128 : Qg;
    const float* fc = (const float*)(ws + WS_FCUM) + (size_t)bh * 4096;

    bf16x8 qf[2][DC];
#pragma unroll
    for (int qs = 0; qs < 2; ++qs)
#pragma unroll
        for (int dc = 0; dc < DC; ++dc) qf[qs][dc] = *(const bf16x8*)(Qg + (size_t)(qs * 16 + fr) * qld + dc * 32 + fq * 8);
    float Fq[2] = {0.f, 0.f}, qb[2] = {0.f, 0.f};
    if (!MLA) {
        const float kmx = __uint_as_float(((const unsigned*)(ws + WS_CTL))[CW_KMAX + l * 64 + bh]);
#pragma unroll
        for (int qs = 0; qs < 2; ++qs) {
            Fq[qs] = fc[wrow0 + qs * 16 + fr] * L2E;
            float ss = 0.f;
#pragma unroll
            for (int dc = 0; dc < 4; ++dc)
#pragma unroll
                for (int e = 0; e < 8; ++e) { const float v = bf2f((u16)qf[qs][dc][e]); ss += v * v; }
            ss += __shfl_xor(ss, 16); ss += __shfl_xor(ss, 32);
            qb[qs] = sqrtf(ss) * kmx * C2 * 1.0001f;
        }
    }
    float m[2] = {-1e30f, -1e30f}, lsum[2] = {0.f, 0.f};
    f32x4 o[2][8];
#pragma unroll
    for (int qs = 0; qs < 2; ++qs)
#pragma unroll
        for (int et = 0; et < 8; ++et) o[qs][et] = f32x4{0.f, 0.f, 0.f, 0.f};

    const int kr = tid >> 4, kc = tid & 15;
    const int swk0 = (kr & 3) | (((kr >> 3) & 3) << 2);
    const int wk0 = kr * 256 + ((kc ^ swk0) * 16);
    const int vr = tid >> 3, vc = tid & 7;
    const int wv0 = 16384 + vr * 128 + ((vc ^ ((vr >> 1) & 7)) * 16);
    const int wp = 32768 + vr * 128 + ((vc ^ (((vr >> 1) & 1) | (((vr >> 3) & 3) << 1))) * 16);
    const int rbase = (fr >> 2) * 8 + (fr & 3);
    int kb0 = rbase * 256 + ((fq ^ (fr & 3)) * 16) + ((fr >> 2) * 64);
    int kp0 = 32768 + rbase * 128 + ((((fq) ^ (fr >> 1)) & 7) * 16);
    int vb0 = 16384 + fr * 128 + ((fr >> 3) * 64) + ((fq ^ ((fr >> 1) & 3)) * 16);

    bf16x8 stk0, stk1, stv0, stv1, stp;
#define LOADT(j_) do { const int s0_ = (j_) * 64; \
        stk0 = *(const bf16x8*)(Kg + (size_t)(s0_ + kr) * kld + kc * 8); stk1 = *(const bf16x8*)(Kg + (size_t)(s0_ + 32 + kr) * kld + kc * 8); \
        stv0 = *(const bf16x8*)(VTg + (size_t)vr * 4096 + s0_ + vc * 8); stv1 = *(const bf16x8*)(VTg + (size_t)(vr + 64) * 4096 + s0_ + vc * 8); \
        if (MLA) stp = *(const bf16x8*)(KPg + (size_t)(s0_ + vr) * 64 + vc * 8); } while (0)
#define WRITET(bf_) do { LAS unsigned char* d_ = lds + (bf_) * BUF; int tl_ = tid; asm volatile("" : "+v"(tl_));     \
        const int kr_ = tl_ >> 4, kc_ = tl_ & 15, vr_ = tl_ >> 3, vc_ = tl_ & 7; \
        const int wk_ = kr_ * 256 + ((kc_ ^ ((kr_ & 3) | (((kr_ >> 3) & 3) << 2))) * 16), wv_ = 16384 + vr_ * 128 + ((vc_ ^ ((vr_ >> 1) & 7)) * 16); \
        *(LAS bf16x8*)(d_ + wk_) = stk0; *(LAS bf16x8*)(d_ + wk_ + 8192) = stk1; *(LAS bf16x8*)(d_ + wv_) = stv0; *(LAS bf16x8*)(d_ + wv_ + 8192) = stv1; \
        if (MLA) *(LAS bf16x8*)(d_ + 32768 + vr_ * 128 + ((vc_ ^ (((vr_ >> 1) & 1) | (((vr_ >> 3) & 3) << 1))) * 16)) = stp; } while (0)

    const int jmax = qt * 4 + 3;
    LOADT(jmax); WRITET(0);
    __syncthreads();
    bf16x8 pfp[2][2]; bool pact = false;
    int cur = 0, prv = 2, nxt = 1;
    for (int j = jmax, it = 0;; --j, ++it) {
        LAS unsigned char* bufp = lds + cur * BUF;
        LAS unsigned char* bufq = lds + prv * BUF;
        if (j > 0) LOADT(j - 1);
        const bool act = (64 * j <= wrow0 + 31);
        asm volatile("" : "+v"(kb0), "+v"(kp0), "+v"(vb0));
#define kbL kb0
#define kpL kp0
#define vbL vb0
        f32x4 sa[2][4];
        if (act) {
#pragma unroll
            for (int qs = 0; qs < 2; ++qs)
#pragma unroll
                for (int kt = 0; kt < 4; ++kt) sa[qs][kt] = f32x4{0.f, 0.f, 0.f, 0.f};
            __builtin_amdgcn_s_setprio(1);
#pragma unroll
            for (int kt = 0; kt < 4; ++kt) {
#pragma unroll
                for (int dc = 0; dc < 4; ++dc) {
                    const bf16x8 kf = *(LAS bf16x8*)(bufp + (kbL ^ (dc << 6)) + (kt >> 1) * 8192 + (kt & 1) * 1024);
                    sa[0][kt] = __builtin_amdgcn_mfma_f32_16x16x32_bf16(kf, qf[0][dc], sa[0][kt], 0, 0, 0);
                    sa[1][kt] = __builtin_amdgcn_mfma_f32_16x16x32_bf16(kf, qf[1][dc], sa[1][kt], 0, 0, 0);
                }
                if (MLA) {
#pragma unroll
                    for (int dcp = 0; dcp < 2; ++dcp) {
                        const bf16x8 kf = *(LAS bf16x8*)(bufp + (kpL ^ (dcp << 6)) + (kt >> 1) * 4096 + (kt & 1) * 512);
                        sa[0][kt] = __builtin_amdgcn_mfma_f32_16x16x32_bf16(kf, qf[0][DC - 2 + dcp], sa[0][kt], 0, 0, 0);
                        sa[1][kt] = __builtin_amdgcn_mfma_f32_16x16x32_bf16(kf, qf[1][DC - 2 + dcp], sa[1][kt], 0, 0, 0);
                    }
                }
            }
            __builtin_amdgcn_s_setprio(0);
        }
        if (pact) {
            __builtin_amdgcn_s_setprio(1);
#pragma unroll
            for (int c32 = 0; c32 < 2; ++c32)
#pragma unroll
                for (int et = 0; et < 8; ++et) {
                    const bf16x8 vf = *(LAS bf16x8*)(bufq + (vbL ^ (c32 << 6)) + et * 2048);
                    o[0][et] = __builtin_amdgcn_mfma_f32_16x16x32_bf16(vf, pfp[0][c32], o[0][et], 0, 0, 0);
                    o[1][et] = __builtin_amdgcn_mfma_f32_16x16x32_bf16(vf, pfp[1][c32], o[1][et], 0, 0, 0);
                }
            __builtin_amdgcn_s_setprio(0);
        }
        if (act) {
            float fkl[2][8];
            if (!MLA) {
#pragma unroll
                for (int c32 = 0; c32 < 2; ++c32) {
                    const float4 a = *(const float4*)(fc + 64 * j + c32 * 32 + fq * 8), c = *(const float4*)(fc + 64 * j + c32 * 32 + fq * 8 + 4);
                    fkl[c32][0] = a.x * L2E; fkl[c32][1] = a.y * L2E; fkl[c32][2] = a.z * L2E; fkl[c32][3] = a.w * L2E;
                    fkl[c32][4] = c.x * L2E; fkl[c32][5] = c.y * L2E; fkl[c32][6] = c.z * L2E; fkl[c32][7] = c.w * L2E;
                }
            }
            const bool needmask = (64 * j + 63 > wrow0);
            bf16x8 pf[2][2];
#pragma unroll
            for (int qs = 0; qs < 2; ++qs) {
                const int row = wrow0 + qs * 16 + fr;
                if (!MLA) {
#pragma unroll
                    for (int kt = 0; kt < 4; ++kt)
#pragma unroll
                        for (int jj = 0; jj < 4; ++jj) sa[qs][kt][jj] = fmaf(sa[qs][kt][jj], C2, Fq[qs] - fkl[kt >> 1][(kt & 1) * 4 + jj]);
                }
                if (needmask) {
#pragma unroll
                    for (int kt = 0; kt < 4; ++kt)
#pragma unroll
                        for (int jj = 0; jj < 4; ++jj) { const int key = 64 * j + (kt >> 1) * 32 + fq * 8 + (kt & 1) * 4 + jj; if (key > row) sa[qs][kt][jj] = -__builtin_inff(); }
                }
                float mx = sa[qs][0][0];
#pragma unroll
                for (int kt = 0; kt < 4; ++kt)
#pragma unroll
                    for (int jj = 0; jj < 4; ++jj) mx = fmaxf(mx, sa[qs][kt][jj]);
                mx = fmaxf(mx, __shfl_xor(mx, 16)); mx = fmaxf(mx, __shfl_xor(mx, 32));
                if (MLA) mx *= C2;
                const float mn = fmaxf(m[qs], mx);
                const float al = __builtin_amdgcn_exp2f(m[qs] - mn);
                m[qs] = mn;
                if (__any(al != 1.f)) {
#pragma unroll
                    for (int et = 0; et < 8; ++et) { o[qs][et][0] *= al; o[qs][et][1] *= al; o[qs][et][2] *= al; o[qs][et][3] *= al; }
                }
                float rs = 0.f;
#pragma unroll
                for (int kt = 0; kt < 4; ++kt)
#pragma unroll
                    for (int jj = 0; jj < 4; ++jj) {
                        const float pv = MLA ? __builtin_amdgcn_exp2f(fmaf(sa[qs][kt][jj], C2, -mn)) : __builtin_amdgcn_exp2f(sa[qs][kt][jj] - mn);
                        rs += pv; sa[qs][kt][jj] = pv;
                    }
                lsum[qs] = lsum[qs] * al + rs;
#pragma unroll
                for (int c32 = 0; c32 < 2; ++c32) {
                    u32x4 w = {pk2(sa[qs][2 * c32][0], sa[qs][2 * c32][1]), pk2(sa[qs][2 * c32][2], sa[qs][2 * c32][3]),
                               pk2(sa[qs][2 * c32 + 1][0], sa[qs][2 * c32 + 1][1]), pk2(sa[qs][2 * c32 + 1][2], sa[qs][2 * c32 + 1][3])};
                    pf[qs][c32] = *reinterpret_cast<bf16x8*>(&w);
                }
            }
            pfp[0][0] = pf[0][0]; pfp[0][1] = pf[0][1]; pfp[1][0] = pf[1][0]; pfp[1][1] = pf[1][1];
        }
        pact = act;
        if (j > 0) WRITET(nxt);
        bool stop = (j == 0);
        if (!MLA && !stop) {
            const float fk1 = fc[64 * j - 1] * L2E;
            const bool c0 = (qb[0] + Fq[0] - fk1 < m[0] - 151.5f), c1 = (qb[1] + Fq[1] - fk1 < m[1] - 151.5f);
            const bool wv = __all(c0 && c1);
            if (lane == 0) ((LAS unsigned*)(lds + VOTE_OFF))[(it & 1) * 8 + wave] = wv ? 1u : 0u;
        }
        __syncthreads();
        if (!MLA && !stop) {
            const u32x4 v0 = *(LAS u32x4*)(lds + VOTE_OFF + (it & 1) * 32), v1 = *(LAS u32x4*)(lds + VOTE_OFF + (it & 1) * 32 + 16);
            stop = (v0[0] & v0[1] & v0[2] & v0[3] & v1[0] & v1[1] & v1[2] & v1[3]) != 0u;
        }
        if (stop) break;
        prv = cur; cur = nxt; nxt = (nxt == 2) ? 0 : nxt + 1;
    }
    if (pact) {
        LAS unsigned char* bufq = lds + cur * BUF;
#pragma unroll
        for (int c32 = 0; c32 < 2; ++c32)
#pragma unroll
            for (int et = 0; et < 8; ++et) {
                const bf16x8 vf = *(LAS bf16x8*)(bufq + (vb0 ^ (c32 << 6)) + et * 2048);
                o[0][et] = __builtin_amdgcn_mfma_f32_16x16x32_bf16(vf, pfp[0][c32], o[0][et], 0, 0, 0);
                o[1][et] = __builtin_amdgcn_mfma_f32_16x16x32_bf16(vf, pfp[1][c32], o[1][et], 0, 0, 0);
            }
    }
#undef LOADT
#undef WRITET
#undef kbL
#undef kpL
#undef vbL
#pragma unroll
    for (int qs = 0; qs < 2; ++qs) {
        float lt = lsum[qs];
        lt += __shfl_xor(lt, 16); lt += __shfl_xor(lt, 32);
        const float inv = 1.f / lt;
        u16* orow = Og + (size_t)(qs * 16 + fr) * 512;
#pragma unroll
        for (int et = 0; et < 8; ++et) {
            f32x4 v = o[qs][et]; v[0] *= inv; v[1] *= inv; v[2] *= inv; v[3] *= inv;
            st4bf(orow + et * 16 + fq * 4, v);
        }
    }
}
constexpr int CW_QUEUE = 6144;
DEVINL void ph_mixers(const Params& p, int l, LAS unsigned char* lds) {
    unsigned* q = (unsigned*)(WSP(p) + WS_CTL) + CW_QUEUE + l * 64;
    LAS unsigned* slot = (LAS unsigned*)(lds + 123008);
    for (;;) {
        __syncthreads();
        if (TID() == 0) *slot = __hip_atomic_fetch_add(q, 1u, __ATOMIC_RELAXED, __HIP_MEMORY_SCOPE_AGENT);
        __syncthreads();
        const int it = (int)__builtin_amdgcn_readfirstlane(*slot);
        if (it >= 64 + 2048) break;
        if (it < 64) retention_unit(p, lds, it);
        else if (it < 64 + 1024) { const int i = it - 64; attn_unit<true>(p, lds, l, i & 63, 15 - (i >> 6)); }
        else { const int i = it - 1088; attn_unit<false>(p, lds, l, i & 63, 15 - (i >> 6)); }
    }
}

struct EpiQ { unsigned char* ws;
    DEVINL bool keep(const GUnit&) const { return false; }
    DEVINL void operator()(const GAcc& acc, const GUnit& u, int wr, int wc, int fr, int fq) const {
        u16* dst = (u16*)(ws + WS_Q);
        const float2* tab = (const float2*)(ws + WS_ROPE);
#pragma unroll
        for (int bj = 0; bj < 2; ++bj) {
            const int cb = G_RUN(u, bj), hh = cb / 192, w = cb - hh * 192;
            if (w >= 128) {
                const int g = (w - 128) >> 5, i0 = 16 * g + 4 * fq;
#pragma unroll
                for (int ai = 0; ai < 2; ++ai)
#pragma unroll
                    for (int m = 0; m < 4; ++m) {
                        int row = G_ROW(u, ai, m); asm volatile("" : "+v"(row));
                        const float4 t0 = *(const float4*)(tab + (size_t)row * 32 + i0), t1 = *(const float4*)(tab + (size_t)row * 32 + i0 + 2);
                        const f32x4 x1 = acc[ai][bj][m][0], x2 = acc[ai][bj][m][1];
                        f32x4 y1, y2;
                        y1[0] = x1[0] * t0.x - x2[0] * t0.y; y2[0] = x2[0] * t0.x + x1[0] * t0.y;
                        y1[1] = x1[1] * t0.z - x2[1] * t0.w; y2[1] = x2[1] * t0.z + x1[1] * t0.w;
                        y1[2] = x1[2] * t1.x - x2[2] * t1.y; y2[2] = x2[2] * t1.x + x1[2] * t1.y;
                        y1[3] = x1[3] * t1.z - x2[3] * t1.w; y2[3] = x2[3] * t1.z + x1[3] * t1.w;
                        u16* rp = dst + (size_t)row * 768 + hh * 192 + 128 + i0;
                        st4bf(rp, y1); st4bf(rp + 32, y2);
                        asm volatile("" ::: "memory");
                    }
            } else {
#pragma unroll
                for (int ai = 0; ai < 2; ++ai)
#pragma unroll
                    for (int m = 0; m < 4; ++m) {
                        st8bf(dst + (size_t)G_ROW(u, ai, m) * 768 + cb + fq * 8, acc[ai][bj][m][0], acc[ai][bj][m][1]);
                    }
            }
        }
    }
};
DEVINL void ph_gemm_mla_up(const Params& p, LAS unsigned char* lds) {
    unsigned char* ws = WSP(p);
    { DenseSched S{(const char*)(ws + WS_MQ), (const char*)(ws + WS_WQ), 256, 256, 256, 3, 0ull};
      gemm_phase_t<false, false, false, false, false>(lds, S, EpiQ{ws}, 256, 256, 256); }
    { DenseSched S{(const char*)(ws + WS_MKV), (const char*)(ws + WS_WKV), 128, 128, 256, 2, 0ull};
      gemm_phase_t<false, false, false, false, false>(lds, S, EpiStore{(u16*)(ws + WS_KN), 512}, 128, 128, 128); }
    { DenseSched S{(const char*)(ws + WS_MKV), (const char*)(ws + WS_WKV), 128, 128, 256, 2, 0x32ull};
      gemm_phase_t<true, false, false, false, false>(lds, S, EpiVT{(u16*)(ws + WS_MVT), 512, (u16*)(ws + WS_MVT), 512, 99}, 128, 128, 128); }
}
struct EpiGate { unsigned char* ws; const float* bias;
    DEVINL bool keep(const GUnit&) const { return false; }
    DEVINL void operator()(const GAcc& acc, const GUnit& u, int wr, int wc, int fr, int fq) const {
        const int i = u.pn >> 2;
        unsigned char* dst = ws + (i == 0 ? WS_G0 : (i == 1 ? WS_G1 : WS_G2));
        const int cg = u.pn * 256 + wc * 64 + fq * 16, cl = cg & 1023;
        float bz[16];
#pragma unroll
        for (int q = 0; q < 4; ++q) { const float4 b4 = *(const float4*)(bias + cg + q * 4); bz[q * 4] = b4.x; bz[q * 4 + 1] = b4.y; bz[q * 4 + 2] = b4.z; bz[q * 4 + 3] = b4.w; }
        constexpr float R = 1.f / W8_SCALE;
#pragma unroll
        for (int ai = 0; ai < 2; ++ai)
#pragma unroll
            for (int m = 0; m < 4; ++m) {
                unsigned w[4];
#pragma unroll
                for (int bj = 0; bj < 2; ++bj)
#pragma unroll
                    for (int n = 0; n < 2; ++n) {
                        const f32x4 v = acc[ai][bj][m][n];
                        unsigned pk = 0u;
#pragma unroll
                        for (int j = 0; j < 4; ++j) pk = __builtin_amdgcn_cvt_pk_u8_f32(fmaxf(rintf(sigmoidf_(fmaf(v[j], R, bz[bj * 8 + n * 4 + j])) * 255.f), 1.f), j, pk);
                        w[bj * 2 + n] = pk;
                    }
                const u32x4 o = {w[0], w[1], w[2], w[3]};
                *(u32x4*)(dst + (size_t)G_ROW(u, ai, m) * 1024 + cl) = o;
            }
    }
};
DEVINL void ph_gates(const Params& p, int l, LAS unsigned char* lds) {
    unsigned char* ws = WSP(p);
    DenseSched S{(const char*)H8P(p), (const char*)(ws + WS_GATE), 512, 512, 256, 12, 0ull};
    gemm_phase_t<false, false, G_SP2, G_ALIGN, true>(lds, S, EpiGate{ws, p.in[I_GATEB] + (size_t)l * 3072}, 512, 512, 512);
}
struct EpiBranch { unsigned char* ws;
    DEVINL bool keep(const GUnit& u) const { return u.sub != 2; }
    DEVINL void operator()(GAcc& acc, const GUnit& u, int wr, int wc, int fr, int fq) const {
        const int i = u.sub;
        const unsigned char* Gc = ws + (i == 0 ? WS_G0 : (i == 1 ? WS_G1 : WS_G2));
        const unsigned char* Gn = ws + (i == 0 ? WS_G1 : WS_G2);
        u16* M = (u16*)(ws + WS_MERGED);
#pragma unroll
        for (int ai = 0; ai < 2; ++ai)
#pragma unroll
            for (int m = 0; m < 4; ++m) {
                const size_t off = (size_t)G_ROW(u, ai, m) * 1024 + u.pn * 256 + wc * 64 + fq * 16;
                const u32x4 g = *(const u32x4*)(Gc + off);
                u32x4 h = g;
                if (i != 2) h = *(const u32x4*)(Gn + off);
#pragma unroll
                for (int bj = 0; bj < 2; ++bj)
#pragma unroll
                    for (int n = 0; n < 2; ++n) {
                        const unsigned gw = g[bj * 2 + n], hw = h[bj * 2 + n];
                        f32x4 v = acc[ai][bj][m][n];
#pragma unroll
                        for (int j = 0; j < 4; ++j) {
                            const float gq = (float)((gw >> (8 * j)) & 255u);
                            v[j] *= (i != 2) ? gq * __builtin_amdgcn_rcpf((float)((hw >> (8 * j)) & 255u)) : gq * (1.f / 255.f);
                        }
                        acc[ai][bj][m][n] = v;
                    }
                if (i == 2) { st8bf(M + off, acc[ai][0][m][0], acc[ai][0][m][1]); st8bf(M + off + 8, acc[ai][1][m][0], acc[ai][1][m][1]); }
            }
    }
};
DEVINL void ph_branch(const Params& p, LAS unsigned char* lds) {
    unsigned char* ws = WSP(p);
    BranchSched S{(const char*)(ws + WS_RG), (const char*)(ws + WS_FQ), (const char*)(ws + WS_YC), (const char*)(ws + WS_BR)};
    gemm_phase(lds, S, EpiBranch{ws}, 512, 512, 512);
}
template <bool XBF>
struct EpiOut { const void* xin; u16* out; const float* gt;
    DEVINL bool keep(const GUnit&) const { return false; }
    DEVINL void operator()(const GAcc& acc, const GUnit& u, int wr, int wc, int fr, int fq) const {
        const int b = u.pm >> 4, c = u.pn * 256 + wc * 64 + fq * 16;
        float g[16];
#pragma unroll
        for (int q = 0; q < 4; ++q) { const float4 g4 = *(const float4*)(gt + b * 6144 + c + q * 4); g[q * 4] = g4.x; g[q * 4 + 1] = g4.y; g[q * 4 + 2] = g4.z; g[q * 4 + 3] = g4.w; }
#pragma unroll
        for (int ai = 0; ai < 2; ++ai)
#pragma unroll
            for (int m = 0; m < 4; ++m) {
                const size_t off = (size_t)G_ROW(u, ai, m) * 1024 + c;
                float xa[16];
                if constexpr (XBF) {
#pragma unroll
                    for (int q = 0; q < 2; ++q) { const u32x4 v = *(const u32x4*)((const u16*)xin + off + q * 8);
                        xa[q * 8 + 0] = lo2f(v[0]); xa[q * 8 + 1] = hi2f(v[0]); xa[q * 8 + 2] = lo2f(v[1]); xa[q * 8 + 3] = hi2f(v[1]); xa[q * 8 + 4] = lo2f(v[2]); xa[q * 8 + 5] = hi2f(v[2]); xa[q * 8 + 6] = lo2f(v[3]); xa[q * 8 + 7] = hi2f(v[3]); }
                } else {
#pragma unroll
                    for (int q = 0; q < 4; ++q) { const float4 v = *(const float4*)((const float*)xin + off + q * 4); xa[q * 4] = v.x; xa[q * 4 + 1] = v.y; xa[q * 4 + 2] = v.z; xa[q * 4 + 3] = v.w; }
                }
#pragma unroll
                for (int bj = 0; bj < 2; ++bj) {
                    const f32x4 a0 = acc[ai][bj][m][0], a1 = acc[ai][bj][m][1];
                    const float* xb = xa + bj * 8; const float* gb = g + bj * 8;
                    const u32x4 o = {pk2(xb[0] + gb[0] * a0[0], xb[1] + gb[1] * a0[1]), pk2(xb[2] + gb[2] * a0[2], xb[3] + gb[3] * a0[3]),
                                     pk2(xb[4] + gb[4] * a1[0], xb[5] + gb[5] * a1[1]), pk2(xb[6] + gb[6] * a1[2], xb[7] + gb[7] * a1[3])};
                    *(u32x4*)(out + off + bj * 8) = o;
                }
            }
    }
};
DEVINL void ph_gemm_out(const Params& p, int l, LAS unsigned char* lds) {
    unsigned char* ws = WSP(p);
    DenseSched S{(const char*)(ws + WS_MERGED), (const char*)(ws + WS_OUTW), 1024, 1024, 256, 4, 0ull};
    const float* gt = (const float*)(ws + WS_MOD) + (size_t)l * 16 * 6144 + 2 * 1024;
    if (l == 0) gemm_phase(lds, S, EpiOut<false>{(const void*)p.in[I_X], (u16*)(ws + WS_XM), gt}, 1024, 1024, 1024);
    else gemm_phase(lds, S, EpiOut<true>{(const void*)p.out, (u16*)(ws + WS_XM), gt}, 1024, 1024, 1024);
}

DEVINL void moe_offsets(const Params& p, int l, LAS int* poff  ) {
    const int tid = TID();
    if (tid < 64) {
        const unsigned* cnt = (const unsigned*)(WSP(p) + WS_CTL) + CW_CNT + l * 32;
        const int r = (tid < 32) ? (int)((cnt[tid] + 255u) & ~255u) : 0;
        int incl = r;
#pragma unroll
        for (int o = 1; o < 32; o <<= 1) { const int n = __shfl_up(incl, o); if (tid >= o) incl += n; }
        if (tid < 32) poff[tid] = incl - r;
        if (tid == 31) poff[32] = incl;
    }
    __syncthreads();
}
DEVINL void ph_scatter(const Params& p, int l, LAS unsigned char* lds) {
    unsigned char* ws = WSP(p);
    LAS int* poff = (LAS int*)lds;
    moe_offsets(p, l, poff);
    int* tokl = (int*)(ws + WS_TOKL); float* wl = (float*)(ws + WS_WL);
    const int4* rt = (const int4*)(ws + WS_ROUTE);
    for (int i = blockIdx.x * NTHR + TID(); i < T_ * 2; i += gridDim.x * NTHR) {
        const int4 r = rt[i];
        const int d = poff[r.x] + r.y;
        tokl[d] = i >> 1; wl[d] = __int_as_float(r.z);
    }
    const unsigned* cnt = (const unsigned*)(ws + WS_CTL) + CW_CNT + l * 32;
    for (int i = blockIdx.x * NTHR + TID(); i < 32 * 256; i += gridDim.x * NTHR) {
        const int e = i >> 8, r = poff[e] + (int)cnt[e] + (i & 255);
        if (r < poff[e + 1]) { tokl[r] = 0; wl[r] = 0.f; }
    }
    __syncthreads();
}
struct EpiUp { unsigned char* hid;
    DEVINL bool keep(const GUnit&) const { return false; }
    DEVINL void operator()(const GAcc& acc, const GUnit& u, int wr, int wc, int fr, int fq) const {
        constexpr float R = 1.f / W8_SCALE;
#pragma unroll
        for (int ai = 0; ai < 2; ++ai)
#pragma unroll
            for (int m = 0; m < 4; ++m) {
                float v[8];
#pragma unroll
                for (int bj = 0; bj < 2; ++bj) {
                    const f32x4 a = acc[ai][bj][m][0], c = acc[ai][bj][m][1];
#pragma unroll
                    for (int j = 0; j < 4; ++j) v[bj * 4 + j] = siluf_(a[j] * R) * (c[j] * R);
                }
                u32x2 o = {pk4_f8(v[0], v[1], v[2], v[3]), pk4_f8(v[4], v[5], v[6], v[7])};
                *(u32x2*)(hid + (size_t)G_ROW(u, ai, m) * 512 + u.pn * 128 + wc * 32 + fq * 8) = o;
            }
    }
};
DEVINL void ph_moe_up(const Params& p, int l, LAS unsigned char* lds) {
    unsigned char* ws = WSP(p);
    LAS int* poff = (LAS int*)(lds + LDS_POFF);
    moe_offsets(p, l, poff);
    MoeGatherSched S{(const char*)(ws + WS_H), (const char*)(ws + WS_W13), 512, (size_t)1024 * 1024, poff, (const int*)(ws + WS_TOKL)};
    gemm_phase_t<false, true, G_SP2, G_ALIGN, true>(lds, S, EpiUp{ws + WS_HID}, 512, 512, 512);
}
struct EpiDown { u16* y; const float* wl;
    DEVINL bool keep(const GUnit&) const { return false; }
    DEVINL void operator()(const GAcc& acc, const GUnit& u, int wr, int wc, int fr, int fq) const {
#pragma unroll
        for (int ai = 0; ai < 2; ++ai)
#pragma unroll
            for (int m = 0; m < 4; ++m) {
                const int row = G_ROW(u, ai, m);
                const float w = wl[row] * (1.f / W8_SCALE);
                u16* rp = y + (size_t)row * 1024 + u.pn * 256 + wc * 64 + fq * 16;
#pragma unroll
                for (int bj = 0; bj < 2; ++bj) {
                    f32x4 v0 = acc[ai][bj][m][0], v1 = acc[ai][bj][m][1];
                    v0[0] *= w; v0[1] *= w; v0[2] *= w; v0[3] *= w; v1[0] *= w; v1[1] *= w; v1[2] *= w; v1[3] *= w;
                    st8bf(rp + bj * 8, v0, v1);
                }
            }
    }
};
DEVINL void ph_moe_down(const Params& p, int l, LAS unsigned char* lds) {
    unsigned char* ws = WSP(p);
    LAS int* poff = (LAS int*)(lds + LDS_POFF);
    moe_offsets(p, l, poff);
    MoeSched S{(const char*)(ws + WS_HID), (const char*)(ws + WS_W2), 256, 256, (size_t)1024 * 512, poff};
    gemm_phase_t<false, false, G_SP2, G_ALIGN, true>(lds, S, EpiDown{(u16*)(ws + WS_YEXP), (const float*)(ws + WS_WL)}, 256, 256, 256);
}

template <bool LAST>
DEVINL void ph_combine(const Params& p, int l, LAS unsigned char* lds) {
    unsigned char* ws = WSP(p);
    LAS int* poff = (LAS int*)lds;
    moe_offsets(p, l, poff);
    const int lane = TID() & 63, gw = blockIdx.x * 8 + (TID() >> 6), GW = gridDim.x * 8;
    const float* mod = (const float*)(ws + WS_MOD) + (size_t)l * 16 * 6144;
    const float* modn = (const float*)(ws + WS_MOD) + (size_t)(l + 1) * 16 * 6144;
    const int4* rt = (const int4*)(ws + WS_ROUTE);
    const u16* Y = (const u16*)(ws + WS_YEXP);
    u16* H = (u16*)(ws + WS_H);
    const u16* XM = (const u16*)(ws + WS_XM);
    unsigned char* H8 = H8P(p);
    u16* X1 = (u16*)p.out;
    for (int t0 = gw * 32; t0 < T_; t0 += GW * 32) {
        const int b = t0 >> 12;
        float gt[16], gs[16], sv[16];
#pragma unroll
        for (int i = 0; i < 4; ++i) { const float4 g4 = *(const float4*)(mod + b * 6144 + 5 * 1024 + i * 256 + lane * 4); gt[i * 4] = g4.x; gt[i * 4 + 1] = g4.y; gt[i * 4 + 2] = g4.z; gt[i * 4 + 3] = g4.w; }
        if (!LAST) norm_consts(p.in[I_N1G] + (size_t)(l + 1) * 1024, modn, modn + 1024, b, lane, gs, sv);
        else {
#pragma unroll
            for (int i = 0; i < 4; ++i) { const float4 g4 = *(const float4*)(p.in[I_FING] + i * 256 + lane * 4); gs[i * 4] = g4.x; gs[i * 4 + 1] = g4.y; gs[i * 4 + 2] = g4.z; gs[i * 4 + 3] = g4.w; }
        }
#pragma unroll 1
        for (int r = 0; r < 32; r += 2) {
            float xv[2][16];
#pragma unroll
            for (int q = 0; q < 2; ++q) {
                const int t = t0 + r + q;
                const int4 r0 = rt[t * 2], r1 = rt[t * 2 + 1];
                const u16* y0 = Y + (size_t)(poff[r0.x] + r0.y) * 1024; const u16* y1 = Y + (size_t)(poff[r1.x] + r1.y) * 1024;
#pragma unroll
                for (int i = 0; i < 4; ++i) {
                    const int c0 = i * 256 + lane * 4;
                    const u32x2 v = *(const u32x2*)(XM + (size_t)t * 1024 + c0);
                    const u32x2 a = *(const u32x2*)(y0 + c0), c = *(const u32x2*)(y1 + c0);
                    xv[q][i * 4 + 0] = lo2f(v[0]) + gt[i * 4 + 0] * (lo2f(a[0]) + lo2f(c[0]));
                    xv[q][i * 4 + 1] = hi2f(v[0]) + gt[i * 4 + 1] * (hi2f(a[0]) + hi2f(c[0]));
                    xv[q][i * 4 + 2] = lo2f(v[1]) + gt[i * 4 + 2] * (lo2f(a[1]) + lo2f(c[1]));
                    xv[q][i * 4 + 3] = hi2f(v[1]) + gt[i * 4 + 3] * (hi2f(a[1]) + hi2f(c[1]));
                }
            }
#pragma unroll
            for (int q = 0; q < 2; ++q) {
                const int t = t0 + r + q;
                if (!LAST) {
#pragma unroll
                    for (int i = 0; i < 4; ++i) { const u32x2 o = {pk2(xv[q][i * 4], xv[q][i * 4 + 1]), pk2(xv[q][i * 4 + 2], xv[q][i * 4 + 3])}; *(u32x2*)(X1 + (size_t)t * 1024 + i * 256 + lane * 4) = o; }
                    norm_store_row(H + (size_t)t * 1024, H8 + (size_t)t * 1024, lane, xv[q], gs, sv);
                } else {
                    float ss = 0.f;
#pragma unroll
                    for (int i = 0; i < 16; ++i) ss += xv[q][i] * xv[q][i];
                    ss = wsum(ss);
                    const float rstd = rsqrtf(ss * (1.f / 1024.f) + EPS);
#pragma unroll
                    for (int i = 0; i < 4; ++i)
                        *(float4*)(p.out + (size_t)t * 1024 + i * 256 + lane * 4) = make_float4(xv[q][i * 4] * rstd * gs[i * 4], xv[q][i * 4 + 1] * rstd * gs[i * 4 + 1], xv[q][i * 4 + 2] * rstd * gs[i * 4 + 2], xv[q][i * 4 + 3] * rstd * gs[i * 4 + 3]);
                }
            }
        }
    }
}

constexpr int NPL = 12, NPHASES = 2 + 2 * NPL;

__global__ void __launch_bounds__(NTHR, 2) mega(Params p) {
    extern __shared__ __attribute__((aligned(16))) unsigned char lds_raw[];
    LAS unsigned char* lds = (LAS unsigned char*)lds_raw;
    LAS unsigned* xbw = (LAS unsigned*)(lds + LDS_BYTES - 16);
    if (threadIdx.x == 0) { xbw[0] = 0u; xbw[1] = 0u; xbw[2] = 0u; xbw[3] = 0u; }
    __syncthreads();
    XcdBarrier bar; bar.bar = (unsigned*)(p.ws + WS_CTL); bar.x = 0; bar.st = (volatile LAS unsigned*)xbw;
    const bool multi = (p.ph_hi - p.ph_lo) > 1;
    if (multi) bar = xcd_barrier_post((unsigned*)(p.ws + WS_CTL), (volatile LAS unsigned*)xbw);
    const int lo = p.ph_lo, hi = p.ph_hi;
#ifdef ONLY
#define PHEN(k) (((k) < 2 ? (k) : 2 + ((k) - 2) % NPL) == ONLY)
#elif defined(SKIP)
#define PHEN(k) (((k) < 2 ? (k) : 2 + ((k) - 2) % NPL) != SKIP)
#else
#define PHEN(k) true
#endif
#define IN(k) (PHEN(k) && lo <= (k) && (k) < hi)
#define SEAM(k) do { if (IN(k) && IN((k) + 1)) xcd_barrier(bar); } while (0)
    unsigned char* ws = p.ws;

    if (IN(0)) { ph_mod(p, lds); ph_rope_table(p); ph_conv_layer(p, 0, lds); }
    SEAM(0);
    if (IN(1)) { ph_rtab(p); ph_norm(p, 0, p.in[I_X], p.in[I_N1G], 0, 1024); }
    SEAM(1);
#pragma unroll
    for (int l = 0; l < 2; ++l) {
        const int pb = 2 + l * NPL;
        if (IN(pb + 0)) ph_gemm_in(p, lds);
        SEAM(pb + 0);
        if (IN(pb + 1)) {
            rmsnorm_inplace<256>((u16*)(ws + WS_MQ), p.in[I_MQG] + l * 256);
            rmsnorm_inplace<128>((u16*)(ws + WS_MKV), p.in[I_MKVG] + l * 128);
            ph_fcum(p, l, lds);
            ph_kmax(p, l);
        }
        SEAM(pb + 1);
        if (IN(pb + 2)) ph_gemm_mla_up(p, lds);
        SEAM(pb + 2);
        if (IN(pb + 3)) ph_mixers(p, l, lds);
        SEAM(pb + 3);
        if (IN(pb + 4)) ph_gates(p, l, lds);
        SEAM(pb + 4);
        if (IN(pb + 5)) ph_branch(p, lds);
        SEAM(pb + 5);
        if (IN(pb + 6)) ph_gemm_out(p, l, lds);
        SEAM(pb + 6);
        if (IN(pb + 7)) ph_norm_route(p, l, lds);
        SEAM(pb + 7);
        if (IN(pb + 8)) ph_scatter(p, l, lds);
        SEAM(pb + 8);
        if (IN(pb + 9)) ph_moe_up(p, l, lds);
        SEAM(pb + 9);
        if (IN(pb + 10)) ph_moe_down(p, l, lds);
        SEAM(pb + 10);
        if (IN(pb + 11)) {
            if (l == 0) { ph_conv_layer(p, 1, lds); ph_combine<false>(p, 0, lds); }
            else ph_combine<true>(p, 1, lds);
        }
        if (l == 0) SEAM(pb + 11);
    }
#undef IN
#undef SEAM
}

extern "C" void kernel_launch(void* const* d_in, const int* in_sizes, int n_in, void* d_out, int out_size, void* d_ws, size_t ws_size, hipStream_t stream) {
    static int grid = 0;
    if (grid == 0) {
        if (n_in != 25 || out_size != T_ * DM || ws_size < WS_END2) { fprintf(stderr, "kernel_launch: unexpected shapes (n_in %d out %d ws %zu)\n", n_in, out_size, ws_size); grid = -1; return; }
        int dev = 0, cus = 0;
        if (hipGetDevice(&dev) != hipSuccess || hipDeviceGetAttribute(&cus, hipDeviceAttributeMultiprocessorCount, dev) != hipSuccess) { grid = -1; return; }
        if (hipFuncSetAttribute((const void*)mega, hipFuncAttributeMaxDynamicSharedMemorySize, LDS_BYTES) != hipSuccess) { fprintf(stderr, "hipFuncSetAttribute failed\n"); grid = -1; return; }
        int per_cu = 0;
        if (hipOccupancyMaxActiveBlocksPerMultiprocessor(&per_cu, (const void*)mega, NTHR, LDS_BYTES) != hipSuccess || per_cu < 1) { fprintf(stderr, "occupancy query: %d\n", per_cu); }
        (void)hipGetLastError();
        grid = cus;
    }
    if (grid < 0) return;
    (void)in_sizes;
    hipMemsetAsync((char*)d_ws + WS_CTL, 0, CTL_ZERO_BYTES, stream);
    Params p{};
    for (int i = 0; i < 25; ++i) p.in[i] = (const float*)d_in[i];
    p.out = (float*)d_out; p.ws = (unsigned char*)d_ws;
#ifndef N_LAUNCH_SPLIT
#define N_LAUNCH_SPLIT 0
#endif
#if N_LAUNCH_SPLIT
    for (int ph = 0; ph < NPHASES; ++ph) { p.ph_lo = ph; p.ph_hi = ph + 1; hipLaunchKernelGGL(mega, dim3(grid), dim3(NTHR), LDS_BYTES, stream, p); }
#else
    p.ph_lo = 0; p.ph_hi = NPHASES; hipLaunchKernelGGL(mega, dim3(grid), dim3(NTHR), LDS_BYTES, stream, p);
#endif
}
```

```cpp
#include <hip/hip_runtime.h>
#include <stdint.h>
#include <stdio.h>

typedef unsigned short u16;
typedef short bf16x8 __attribute__((ext_vector_type(8)));
typedef float f32x4 __attribute__((ext_vector_type(4)));
typedef unsigned u32x2 __attribute__((ext_vector_type(2)));
typedef unsigned u32x4 __attribute__((ext_vector_type(4)));
#define LAS __attribute__((address_space(3)))
#define DEVINL __device__ __forceinline__

constexpr int T_ = 65536, DM = 1024, NBATCH = 16, SEQ = 4096, NTHR = 512;
constexpr int PROWS = 131072 + 32 * 256;
constexpr float EPS = 1e-6f;

enum { I_X = 0, I_C, I_POS, I_ADAW, I_ADAB, I_N1G, I_N2G, I_WIN, I_FOXFB, I_MQG, I_WQUP, I_MKVG, I_WKVUP, I_GATEW, I_GATEB,
       I_BRW, I_OUTW, I_RGW, I_RGB, I_REW, I_REB, I_W1, I_W3, I_W2, I_FING };

constexpr size_t MB = 1ull << 20;
constexpr size_t WS_CTL = 0, WS_MOD = 1 * MB, WS_FCUM = 2 * MB, WS_FFL = 3 * MB, WS_ROUTE = 4 * MB, WS_TOKL = 6 * MB, WS_WL = 7 * MB,
                 WS_ROPE = 8 * MB, WS_WIN = 24 * MB, WS_GATE = 31 * MB, WS_BR = 37 * MB, WS_OUTW = 40 * MB, WS_WQ = 42 * MB,
                 WS_WKV = 43 * MB, WS_W13 = 44 * MB, WS_W2 = 108 * MB, WS_H = 140 * MB, WS_RQK = 268 * MB, WS_RV = 332 * MB,
                 WS_RG = 396 * MB, WS_FQ = 460 * MB, WS_FK = 524 * MB, WS_FV = 588 * MB, WS_MQ = 652 * MB, WS_MKV = 684 * MB,
                 WS_KPE = 700 * MB, WS_Q = 708 * MB, WS_KV = 804 * MB, WS_END = 932 * MB,
                 WS_HID = 268 * MB, WS_YEXP = 404 * MB, WS_MERGED = WS_H,
                 WS_FVT = WS_FV, WS_RVT = WS_RV, WS_KN = WS_KV, WS_MVT = WS_KV + 64 * MB, WS_XM = WS_KV,

                 WS_YC = 932 * MB, WS_G0 = WS_RQK, WS_G1 = WS_FK, WS_G2 = WS_KV, WS_RTAB = 996 * MB, WS_RCJ = 1003 * MB, WS_END2 = 1004 * MB,
                 WS_H8A = WS_W13 + 32 * MB, WS_H8B = WS_MQ;
constexpr size_t CTL_ZERO_BYTES = 64 * 1024;
constexpr int CW_CNT = 4096;
constexpr int CW_KMAX = 4224;

constexpr int LDS_BYTES = 146 * 1024;

struct Params { const float* in[25]; float* out; unsigned char* ws; int ph_lo, ph_hi; };

DEVINL float bf2f(u16 v) { return __uint_as_float(((unsigned)v) << 16); }
DEVINL u16 f2bf(float f) { unsigned u = __float_as_uint(f); u += 0x7FFFu + ((u >> 16) & 1u); return (u16)(u >> 16); }
typedef float f32x2 __attribute__((ext_vector_type(2)));
typedef __bf16 bf16x2_t __attribute__((ext_vector_type(2)));
DEVINL unsigned pk2(float lo, float hi) { f32x2 v = {lo, hi}; bf16x2_t b = __builtin_convertvector(v, bf16x2_t); return *reinterpret_cast<unsigned*>(&b); }
typedef int v8i __attribute__((ext_vector_type(8)));
typedef int v4i __attribute__((ext_vector_type(4)));
DEVINL unsigned pk4_f8(float a, float b, float c, float d) { int w = __builtin_amdgcn_cvt_pk_fp8_f32(a, b, 0, false); w = __builtin_amdgcn_cvt_pk_fp8_f32(c, d, w, true); return (unsigned)w; }
DEVINL float lo2f(unsigned v) { return __uint_as_float(v << 16); }
DEVINL float hi2f(unsigned v) { return __uint_as_float(v & 0xFFFF0000u); }
DEVINL float wsum(float v) { for (int o = 32; o; o >>= 1) v += __shfl_xor(v, o); return v; }
DEVINL float sigmoidf_(float x) { return __builtin_amdgcn_rcpf(1.f + __builtin_amdgcn_exp2f(x * -1.4426950408889634f)); }
DEVINL float siluf_(float x) { return x * __builtin_amdgcn_rcpf(1.f + __builtin_amdgcn_exp2f(x * -1.4426950408889634f)); }

__device__ const float ROPE_INV[32] = {
    1.000000000e+00f, 7.498942614e-01f, 5.623413324e-01f, 4.216965139e-01f, 3.162277639e-01f, 2.371373773e-01f, 1.778279394e-01f, 1.333521307e-01f,
    1.000000015e-01f, 7.498941571e-02f, 5.623413250e-02f, 4.216965288e-02f, 3.162277490e-02f, 2.371373773e-02f, 1.778279431e-02f, 1.333521493e-02f,
    9.999999776e-03f, 7.498941850e-03f, 5.623413250e-03f, 4.216964822e-03f, 3.162277630e-03f, 2.371373586e-03f, 1.778279431e-03f, 1.333521446e-03f,
    1.000000047e-03f, 7.498942432e-04f, 5.623413017e-04f, 4.216965172e-04f, 3.162277571e-04f, 2.371373703e-04f, 1.778279402e-04f, 1.333521504e-04f};

#define XB_TMO      128
#define XB_XCNT(j)  (256  + 64 * (j))
#define XB_XSUB(j)  (1280 + 64 * (j))
#define XB_XGEN(j)  (2304 + 64 * (j))
#define XB_TOP      3328
#define XB_TOPGEN   3392
#define XCD_BAR_WORDS 3456
#define XB_SPIN_CAP (1u << 20)

__device__ __forceinline__ unsigned xb_ld(unsigned* p)              { return __hip_atomic_load(p, __ATOMIC_RELAXED, __HIP_MEMORY_SCOPE_AGENT); }
__device__ __forceinline__ unsigned xb_add(unsigned* p, unsigned v) { return __hip_atomic_fetch_add(p, v, __ATOMIC_RELAXED, __HIP_MEMORY_SCOPE_AGENT); }
__device__ __forceinline__ unsigned xb_xcc_id() { return (unsigned)__builtin_amdgcn_s_getreg((3 << 11) | 20) & 0xFu; }
#define XB_SPIN(cond, bar) do { unsigned _sp = 0; while (cond) { __builtin_amdgcn_s_sleep(1); \
    if ((++_sp & 255u) == 0u) { if (xb_ld(&(bar)[XB_TMO])) break; if (_sp > XB_SPIN_CAP) { atomicAdd(&(bar)[XB_TMO], 1u); break; } } } } while (0)

struct XcdBarrier { unsigned* bar; unsigned x; volatile LAS unsigned* st; };

__device__ __forceinline__ XcdBarrier xcd_barrier_post(unsigned* bar, volatile LAS unsigned* st) {
    XcdBarrier b; b.bar = bar; b.x = xb_xcc_id(); b.st = st;
    if (threadIdx.x == 0) (void)xb_add(&bar[XB_XCNT(b.x)], 1u);
    return b;
}
__device__ __forceinline__ void xcd_barrier_complete(unsigned* bar, unsigned x, unsigned& nloc, unsigned& nx) {
    const unsigned G = gridDim.x * gridDim.y * gridDim.z;
    unsigned sum, cnt, mine, sp = 0u;
    for (;;) {
        sum = 0u; cnt = 0u; mine = 0u;
#pragma unroll
        for (unsigned j = 0; j < 16; ++j) { const unsigned c = xb_ld(&bar[XB_XCNT(j)]); sum += c; cnt += (c > 0u) ? 1u : 0u; mine = (j == x) ? c : mine; }
        if (sum == G) break;
        __builtin_amdgcn_s_sleep(1);
        if ((++sp & 255u) == 0u) { if (xb_ld(&bar[XB_TMO])) break; if (sp > XB_SPIN_CAP) { atomicAdd(&bar[XB_TMO], 1u); break; } }
    }
    nloc = mine > 0u ? mine : 1u; nx = cnt > 0u ? cnt : 1u;
}
__device__ __forceinline__ void xcd_barrier(const XcdBarrier& b) {
    asm volatile("s_waitcnt vmcnt(0)" ::: "memory");
    __syncthreads();
    if (threadIdx.x == 0) {
        unsigned* bar = b.bar;
        __builtin_amdgcn_s_waitcnt(0);
        unsigned nloc = b.st[0], nx = b.st[1];
        if (nloc == 0u) { xcd_barrier_complete(bar, b.x, nloc, nx); b.st[0] = nloc; b.st[1] = nx; }
        const unsigned old = xb_add(&bar[XB_XSUB(b.x)], 1u);
        const unsigned gen = old / nloc;
        if (old + 1u == (gen + 1u) * nloc) {
            __builtin_amdgcn_fence(__ATOMIC_RELEASE, "agent");
            asm volatile("s_waitcnt vmcnt(0)" ::: "memory");
            const unsigned og = xb_add(&bar[XB_TOP], 1u);
            const unsigned tg = og / nx;
            if (og + 1u == (tg + 1u) * nx) xb_add(&bar[XB_TOPGEN], 1u);
            else XB_SPIN(xb_ld(&bar[XB_TOPGEN]) == tg, bar);
            __builtin_amdgcn_fence(__ATOMIC_ACQUIRE, "agent");
            xb_add(&bar[XB_XGEN(b.x)], 1u);
            asm volatile("s_waitcnt vmcnt(0)" ::: "memory");
        } else {
            XB_SPIN(xb_ld(&bar[XB_XGEN(b.x)]) == gen, bar);
            __builtin_amdgcn_fence(__ATOMIC_ACQUIRE, "agent");
            asm volatile("s_waitcnt vmcnt(0)" ::: "memory");
        }
    }
    __syncthreads();
}

DEVINL int BID() { int b = blockIdx.x; asm volatile("" : "+s"(b)); return b; }
DEVINL int TID() { int t = threadIdx.x; asm volatile("" : "+v"(t)); return t; }
DEVINL unsigned char* WSP(const Params& p) { unsigned char* w = p.ws; asm volatile("" : "+s"(w)); return w; }

DEVINL void ph_mod(const Params& p, LAS unsigned char* lds) {
    LAS float* cact = (LAS float*)lds;
    LAS float* red = (LAS float*)(lds + 65536);
    const int tid = TID(), lane = tid & 63, wave = tid >> 6;
    if ((int)blockIdx.x >= 48) return;
    const float* c = p.in[I_C];
#pragma unroll 8
    for (int i = tid; i < 16 * 1024; i += NTHR) cact[i] = siluf_(c[i]);
    __syncthreads();
    float* mod = (float*)(WSP(p) + WS_MOD);
    for (int u = blockIdx.x; u < 48; u += gridDim.x) {
        const int l = u / 24, cb = u % 24;
        const float* w = p.in[I_ADAW] + (size_t)l * 1024 * 6144 + cb * 256 + lane * 4;
        float acc[16][4];
#pragma unroll
        for (int bb = 0; bb < 16; ++bb) { acc[bb][0] = 0.f; acc[bb][1] = 0.f; acc[bb][2] = 0.f; acc[bb][3] = 0.f; }
#pragma unroll 1
        for (int k0 = wave * 128; k0 < wave * 128 + 128; k0 += 4) {
            float4 wv[4];
#pragma unroll
            for (int j = 0; j < 4; ++j) wv[j] = *(const float4*)(w + (size_t)(k0 + j) * 6144);
#pragma unroll
            for (int j = 0; j < 4; ++j)
#pragma unroll
                for (int bb = 0; bb < 16; ++bb) { const float cv = cact[bb * 1024 + k0 + j]; acc[bb][0] += cv * wv[j].x; acc[bb][1] += cv * wv[j].y; acc[bb][2] += cv * wv[j].z; acc[bb][3] += cv * wv[j].w; }
        }
#pragma unroll
        for (int rnd = 0; rnd < 2; ++rnd) {
#pragma unroll
            for (int bb = 0; bb < 8; ++bb) *(LAS f32x4*)(red + ((wave * 8 + bb) * 256 + lane * 4)) = f32x4{acc[rnd * 8 + bb][0], acc[rnd * 8 + bb][1], acc[rnd * 8 + bb][2], acc[rnd * 8 + bb][3]};
            __syncthreads();
            for (int o = tid; o < 8 * 256; o += NTHR) {
                const int bb = o >> 8, jj = o & 255;
                float sum = 0.f;
#pragma unroll
                for (int q = 0; q < 8; ++q) sum += red[(q * 8 + bb) * 256 + jj];
                const int jg = cb * 256 + jj;
                mod[((size_t)l * 16 + rnd * 8 + bb) * 6144 + jg] = sum + p.in[I_ADAB][l * 6144 + jg];
            }
            __syncthreads();
        }
    }
}

DEVINL void ph_rope_table(const Params& p) {
    const int* pos = (const int*)p.in[I_POS];
    float2* tab = (float2*)(WSP(p) + WS_ROPE);
    for (int idx = blockIdx.x * NTHR + TID(); idx < T_ * 32; idx += gridDim.x * NTHR) {
        const int t = idx >> 5, i = idx & 31;
        const float ang = (float)pos[t] * ROPE_INV[i];
        const double a = (double)ang;
        const double k = rint(a * 0.15915494309189535);
        const double r = a - k * 6.283185307179586;
        const double q = rint(r * 0.6366197723675814);
        const double y = r - q * 1.5707963267948966;
        const double y2 = y * y;
        const double sn = y * (1.0 + y2 * (-1.0 / 6 + y2 * (1.0 / 120 + y2 * (-1.0 / 5040 + y2 * (1.0 / 362880 + y2 * (-1.0 / 39916800))))));
        const double cs = 1.0 + y2 * (-0.5 + y2 * (1.0 / 24 + y2 * (-1.0 / 720 + y2 * (1.0 / 40320 + y2 * (-1.0 / 3628800 + y2 * (1.0 / 479001600))))));
        const int qi = ((int)q) & 3;
        double co, si;
        if (qi == 0) { co = cs; si = sn; } else if (qi == 1) { co = -sn; si = cs; } else if (qi == 2) { co = -cs; si = -sn; } else { co = sn; si = -cs; }
        tab[idx] = make_float2((float)co, (float)si);
    }
}

DEVINL int p8(int n) { return (n & ~31) + ((n >> 2) & 1) * 16 + ((n >> 3) & 3) * 4 + (n & 3); }
DEVINL int rope_pos(int i) { return i < 32 ? ((i >> 4) * 32 + (i & 15)) : (((i - 32) >> 4) * 32 + 16 + ((i - 32) & 15)); }
template <int MAP> DEVINL int nmap(int n) {
    if (MAP == 1) {
        if (n < 512) return (n & ~63) + rope_pos(n & 63);
        if (n < 1024) return n;
        if (n < 2560) return p8(n);
        if (n < 3072) return n;
        if (n < 3076) return 3520 + (n - 3072);
        if (n < 3460) return p8(n - 4);
        return 3456 + rope_pos(n - 3460);
    }
    if (MAP == 4) { const int hh = n / 192, w = n - hh * 192; return w < 128 ? p8(n) : hh * 192 + 128 + rope_pos(w - 128); }
    if (MAP == 5) { const int hh = n >> 8, c = n & 255; return c < 128 ? p8(hh * 128 + c) : 512 + hh * 128 + (c - 128); }
    if (MAP == 2) return (n >> 7) * 256 + ((n >> 2) & 1) * 128 + ((n >> 5) & 3) * 32 + ((n >> 3) & 3) * 4 + (n & 3);
    if (MAP == 3) return (n >> 7) * 256 + ((n >> 2) & 1) * 128 + ((n >> 5) & 3) * 32 + 16 + ((n >> 3) & 3) * 4 + (n & 3);
    if (MAP == 6) return p8(n);
    if (MAP == 7) { const int c = n & 255; return (n & ~255) + ((c >> 3) & 1) * 128 + (c >> 6) * 32 + ((c >> 2) & 1) * 16 + ((c >> 4) & 3) * 4 + (c & 3); }
    return n;
}
constexpr float W8_SCALE = 64.f;
template <int MAP, bool F8>
DEVINL void conv_wx(const float* src, int nb, int K, int N, int Ntiles64, void* dst, size_t dst_bstride, LAS unsigned char* lds) {
    LAS float* tile = (LAS float*)lds;
    const int tid = TID(), c = tid & 63, r0 = tid >> 6;
    const int kt_n = K / 128, per_b = kt_n * Ntiles64, total = nb * per_b;
    float ld[16];
    int u = blockIdx.x;
#define CONV_LOAD(uu) do { const int b_ = (uu) / per_b, rem_ = (uu) % per_b, kt_ = rem_ / Ntiles64, nt_ = rem_ % Ntiles64; const float* s_ = src + (size_t)b_ * K * N; const int n_ = nt_ * 64 + c; \
        _Pragma("unroll") for (int i = 0; i < 16; ++i) { const int r = r0 + i * 8; ld[i] = (n_ < N) ? s_[(size_t)(kt_ * 128 + r) * N + n_] : 0.f; } } while (0)
    if (u < total) CONV_LOAD(u);
    for (; u < total; u += gridDim.x) {
        const int b = u / per_b, rem = u % per_b, kt = rem / Ntiles64, nt = rem % Ntiles64;
#pragma unroll
        for (int i = 0; i < 16; ++i) tile[(r0 + i * 8) * 65 + c] = F8 ? ld[i] * W8_SCALE : ld[i];
        __syncthreads();
        if (u + (int)gridDim.x < total) CONV_LOAD(u + (int)gridDim.x);
#pragma unroll
        for (int i = 0; i < 2; ++i) {
            const int item = tid + i * NTHR, rn = item >> 4, kg = item & 15, nn = nt * 64 + rn;
            const int drow = (nn < N) ? nmap<MAP>(nn) : nn;
            float v[8];
#pragma unroll
            for (int j = 0; j < 8; ++j) v[j] = tile[(kg * 8 + j) * 65 + rn];
            if constexpr (F8) {
                u32x2 o = {pk4_f8(v[0], v[1], v[2], v[3]), pk4_f8(v[4], v[5], v[6], v[7])};
                *(u32x2*)((unsigned char*)dst + (size_t)b * dst_bstride + (size_t)drow * K + kt * 128 + kg * 8) = o;
            } else {
                u32x4 o = {pk2(v[0], v[1]), pk2(v[2], v[3]), pk2(v[4], v[5]), pk2(v[6], v[7])};
                *(u32x4*)((u16*)dst + (size_t)b * dst_bstride + (size_t)drow * K + kt * 128 + kg * 8) = o;
            }
        }
        __syncthreads();
    }
#undef CONV_LOAD
}
template <int MAP> DEVINL void conv_w(const float* src, int nb, int K, int N, int Ntiles64, u16* dst, size_t dst_bstride, LAS unsigned char* lds) { conv_wx<MAP, false>(src, nb, K, N, Ntiles64, dst, dst_bstride, lds); }
template <int MAP> DEVINL void conv_w8(const float* src, int nb, int K, int N, int Ntiles64, unsigned char* dst, size_t dst_bstride, LAS unsigned char* lds) { conv_wx<MAP, true>(src, nb, K, N, Ntiles64, dst, dst_bstride, lds); }
DEVINL void ph_conv_layer(const Params& p, int l, LAS unsigned char* lds) {
    unsigned char* ws = WSP(p);
    conv_w<1>(p.in[I_WIN] + (size_t)l * 1024 * 3524, 1, 1024, 3524, 56, (u16*)(ws + WS_WIN), 0, lds);
    conv_w8<7>(p.in[I_GATEW] + (size_t)l * 1024 * 3072, 1, 1024, 3072, 48, ws + WS_GATE, 0, lds);
    conv_w<7>(p.in[I_BRW] + (size_t)l * 3 * 512 * 1024, 3, 512, 1024, 16, (u16*)(ws + WS_BR), (size_t)1024 * 512, lds);
    conv_w<7>(p.in[I_OUTW] + (size_t)l * 1024 * 1024, 1, 1024, 1024, 16, (u16*)(ws + WS_OUTW), 0, lds);
    conv_w<4>(p.in[I_WQUP] + (size_t)l * 256 * 768, 1, 256, 768, 12, (u16*)(ws + WS_WQ), 0, lds);
    conv_w<5>(p.in[I_WKVUP] + (size_t)l * 128 * 1024, 1, 128, 1024, 16, (u16*)(ws + WS_WKV), 0, lds);
    conv_w8<2>(p.in[I_W1] + (size_t)l * 32 * 1024 * 512, 32, 1024, 512, 8, ws + WS_W13, (size_t)1024 * 1024, lds);
    conv_w8<3>(p.in[I_W3] + (size_t)l * 32 * 1024 * 512, 32, 1024, 512, 8, ws + WS_W13, (size_t)1024 * 1024, lds);
    conv_w8<7>(p.in[I_W2] + (size_t)l * 32 * 512 * 1024, 32, 512, 1024, 16, ws + WS_W2, (size_t)1024 * 512, lds);
}

DEVINL unsigned char* H8P(const Params& p) { return (unsigned char*)p.out + (size_t)128 * MB; }
DEVINL void norm_consts(const float* g, const float* sh, const float* sc, int b, int lane, float (&gs)[16], float (&sv)[16]) {
#pragma unroll
    for (int i = 0; i < 4; ++i) {
        const int c0 = i * 256 + lane * 4;
        const float4 gv = *(const float4*)(g + c0), shv = *(const float4*)(sh + b * 6144 + c0), scv = *(const float4*)(sc + b * 6144 + c0);
        gs[i * 4 + 0] = gv.x * (1.f + scv.x); gs[i * 4 + 1] = gv.y * (1.f + scv.y); gs[i * 4 + 2] = gv.z * (1.f + scv.z); gs[i * 4 + 3] = gv.w * (1.f + scv.w);
        sv[i * 4 + 0] = shv.x; sv[i * 4 + 1] = shv.y; sv[i * 4 + 2] = shv.z; sv[i * 4 + 3] = shv.w;
    }
}
DEVINL void norm_store_row_f8(unsigned char* Hrow, int lane, const float (&xv)[16], const float (&gs)[16], const float (&sv)[16]) {
    float ss = 0.f;
#pragma unroll
    for (int i = 0; i < 16; ++i) ss += xv[i] * xv[i];
    ss = wsum(ss);
    const float rstd = rsqrtf(ss * (1.f / 1024.f) + EPS);
#pragma unroll
    for (int i = 0; i < 4; ++i)
        *(unsigned*)(Hrow + i * 256 + lane * 4) = pk4_f8(xv[i * 4 + 0] * rstd * gs[i * 4 + 0] + sv[i * 4 + 0], xv[i * 4 + 1] * rstd * gs[i * 4 + 1] + sv[i * 4 + 1],
                                                      xv[i * 4 + 2] * rstd * gs[i * 4 + 2] + sv[i * 4 + 2], xv[i * 4 + 3] * rstd * gs[i * 4 + 3] + sv[i * 4 + 3]);
}
DEVINL void norm_store_row(u16* Hrow, unsigned char* H8row, int lane, const float (&xv)[16], const float (&gs)[16], const float (&sv)[16]) {
    float ss = 0.f;
#pragma unroll
    for (int i = 0; i < 16; ++i) ss += xv[i] * xv[i];
    ss = wsum(ss);
    const float rstd = rsqrtf(ss * (1.f / 1024.f) + EPS);
#pragma unroll
    for (int i = 0; i < 4; ++i) {
        const float v0 = xv[i * 4 + 0] * rstd * gs[i * 4 + 0] + sv[i * 4 + 0], v1 = xv[i * 4 + 1] * rstd * gs[i * 4 + 1] + sv[i * 4 + 1];
        const float v2 = xv[i * 4 + 2] * rstd * gs[i * 4 + 2] + sv[i * 4 + 2], v3 = xv[i * 4 + 3] * rstd * gs[i * 4 + 3] + sv[i * 4 + 3];
        u32x2 o = {pk2(v0, v1), pk2(v2, v3)};
        *(u32x2*)(Hrow + i * 256 + lane * 4) = o;
        *(unsigned*)(H8row + i * 256 + lane * 4) = pk4_f8(lo2f(o[0]), hi2f(o[0]), lo2f(o[1]), hi2f(o[1]));
    }
}

DEVINL void ph_norm(const Params& p, int l, const float* xin, const float* g, int sh_off, int sc_off) {
    const int lane = TID() & 63, gw = blockIdx.x * 8 + (TID() >> 6), GW = gridDim.x * 8;
    const float* mod = (const float*)(WSP(p) + WS_MOD) + (size_t)l * 16 * 6144;
    u16* H = (u16*)(WSP(p) + WS_H);
    unsigned char* H8 = H8P(p);
    for (int t0 = gw * 32; t0 < T_; t0 += GW * 32) {
        float gs[16], sv[16];
        norm_consts(g, mod + sh_off, mod + sc_off, t0 >> 12, lane, gs, sv);
#pragma unroll 1
        for (int r = 0; r < 32; r += 2) {
            float xa[16], xb[16];
#pragma unroll
            for (int i = 0; i < 4; ++i) {
                const float4 v = *(const float4*)(xin + (size_t)(t0 + r) * 1024 + i * 256 + lane * 4), w = *(const float4*)(xin + (size_t)(t0 + r + 1) * 1024 + i * 256 + lane * 4);
                xa[i * 4] = v.x; xa[i * 4 + 1] = v.y; xa[i * 4 + 2] = v.z; xa[i * 4 + 3] = v.w; xb[i * 4] = w.x; xb[i * 4 + 1] = w.y; xb[i * 4 + 2] = w.z; xb[i * 4 + 3] = w.w;
            }
            norm_store_row(H + (size_t)(t0 + r) * 1024, H8 + (size_t)(t0 + r) * 1024, lane, xa, gs, sv);
            norm_store_row(H + (size_t)(t0 + r + 1) * 1024, H8 + (size_t)(t0 + r + 1) * 1024, lane, xb, gs, sv);
        }
    }
}

constexpr int RT_WH = 0, RT_WL = 49152, RT_CJ = 98304, RT_CNT = 98304 + 256;
DEVINL int rt_col(int r) { const int s_ = r >> 4, g_ = (r >> 2) & 3, j_ = r & 3; return s_ == 2 ? j_ : 4 + g_ * 8 + s_ * 4 + j_; }
DEVINL void ph_rtab(const Params& p) {
    unsigned char* ws = WSP(p);
    const int tid = TID(), lane = tid & 63, gw = blockIdx.x * 8 + (tid >> 6), GW = gridDim.x * 8;
    for (int idx = blockIdx.x * NTHR + tid; idx < 2 * 16 * 48 * 1024; idx += gridDim.x * NTHR) {
        const int lb = idx / (48 * 1024), rem = idx - lb * (48 * 1024), k = rem / 48, r = rem - k * 48, l = lb >> 4, b = lb & 15, col = rt_col(r);
        const float* mod = (const float*)(ws + WS_MOD) + (size_t)l * 16 * 6144 + b * 6144;
        const float wsrc = (col < 4) ? p.in[I_RGW][(size_t)l * 1024 * 4 + k * 4 + col] : p.in[I_REW][(size_t)l * 1024 * 32 + k * 32 + (col - 4)];
        const float w = p.in[I_N2G][l * 1024 + k] * (1.f + mod[4 * 1024 + k]) * wsrc;
        const u16 hi = (u16)(pk2(w, 0.f) & 0xFFFFu);
        const u16 lo = (u16)(pk2(w - bf2f(hi), 0.f) & 0xFFFFu);
        const int hf = k >> 9, kk = k & 511;
        unsigned char* img = ws + WS_RTAB + (size_t)(lb * 2 + hf) * 98304;
        const int off = r * 1024 + (((kk >> 3) ^ (r & 15)) * 16) + (kk & 7) * 2;
        *(u16*)(img + off) = hi; *(u16*)(img + 49152 + off) = lo;
    }
    for (int it = gw; it < 2 * 16 * 48; it += GW) {
        const int lb = it / 48, r = it - lb * 48, l = lb >> 4, b = lb & 15, col = rt_col(r);
        const float* sh = (const float*)(ws + WS_MOD) + (size_t)l * 16 * 6144 + b * 6144 + 3 * 1024;
        float a_ = 0.f;
        for (int k = lane; k < 1024; k += 64) a_ += sh[k] * ((col < 4) ? p.in[I_RGW][(size_t)l * 1024 * 4 + k * 4 + col] : p.in[I_REW][(size_t)l * 1024 * 32 + k * 32 + (col - 4)]);
        a_ = wsum(a_);
        if (lane == 0) ((float*)(ws + WS_RCJ))[it] = a_ + ((col < 4) ? p.in[I_RGB][l * 4 + col] : p.in[I_REB][l * 32 + (col - 4)]);
    }
}
DEVINL void ph_norm_route(const Params& p, int l, LAS unsigned char* lds) {
    unsigned char* ws = WSP(p);
    const int tid = TID(), lane = tid & 63, wave = __builtin_amdgcn_readfirstlane(tid >> 6), fr = lane & 15, fq = lane >> 4;
    const u16* x = (const u16*)(ws + WS_XM);
    const float* g2 = p.in[I_N2G] + (size_t)l * 1024;
    const float* mod = (const float*)(ws + WS_MOD) + (size_t)l * 16 * 6144;
    const float* wg = p.in[I_RGW] + (size_t)l * 1024 * 4;
    const float* we = p.in[I_REW] + (size_t)l * 1024 * 32;
    LAS float* cj = (LAS float*)(lds + RT_CJ);
    LAS unsigned* lcnt = (LAS unsigned*)(lds + RT_CNT);
    for (int blk = blockIdx.x; blk < 256; blk += gridDim.x) {
        const int b = blk >> 4;
        const float* sh = mod + b * 6144 + 3 * 1024; const float* sc = mod + b * 6144 + 4 * 1024;
        f32x4 acc[3][2];
#pragma unroll
        for (int s_ = 0; s_ < 3; ++s_) { acc[s_][0] = f32x4{0.f, 0.f, 0.f, 0.f}; acc[s_][1] = f32x4{0.f, 0.f, 0.f, 0.f}; }
        float ssq[2] = {0.f, 0.f};
        const u16* xr0 = x + (size_t)(blk * 256 + wave * 32 + fr) * 1024 + fq * 8;
#pragma unroll 1
        for (int hf = 0; hf < 2; ++hf) {
            {
                const u32x4* img = (const u32x4*)(ws + WS_RTAB + (size_t)((l * 16 + b) * 2 + hf) * 98304);
                u32x4 tv[12];
#pragma unroll
                for (int q = 0; q < 12; ++q) tv[q] = img[q * NTHR + tid];
#pragma unroll
                for (int q = 0; q < 12; ++q) *(LAS u32x4*)(lds + RT_WH + (q * NTHR + tid) * 16) = tv[q];
            }
            if (hf == 0) {
                if (tid < 32) lcnt[tid] = 0u;
                if (tid < 48) cj[tid] = ((const float*)(ws + WS_RCJ))[(l * 16 + b) * 48 + tid];
            }
            __syncthreads();
            const u16* xk = xr0 + hf * 512;
#pragma unroll 1
            for (int kg = 0; kg < 2; ++kg) {
                u32x4 xv[8][2];
#pragma unroll
                for (int q = 0; q < 8; ++q)
#pragma unroll
                    for (int ts = 0; ts < 2; ++ts) xv[q][ts] = *(const u32x4*)(xk + (kg * 8 + q) * 32 + ts * 16 * 1024);
#pragma unroll
                for (int q = 0; q < 8; ++q) {
                    const int ks = kg * 8 + q;
                    bf16x8 xh[2];
#pragma unroll
                    for (int ts = 0; ts < 2; ++ts) {
#pragma unroll
                        for (int e = 0; e < 4; ++e) { const float a_ = lo2f(xv[q][ts][e]), b_ = hi2f(xv[q][ts][e]); ssq[ts] += a_ * a_ + b_ * b_; }
                        xh[ts] = *reinterpret_cast<bf16x8*>(&xv[q][ts]);
                    }
#pragma unroll
                    for (int s_ = 0; s_ < 3; ++s_) {
                        const int off = (s_ * 16 + fr) * 1024 + (((ks * 4 + fq) ^ fr) * 16);
                        const bf16x8 wh = *(const LAS bf16x8*)(lds + RT_WH + off), wl = *(const LAS bf16x8*)(lds + RT_WL + off);
#pragma unroll
                        for (int ts = 0; ts < 2; ++ts) {
                            acc[s_][ts] = __builtin_amdgcn_mfma_f32_16x16x32_bf16(wh, xh[ts], acc[s_][ts], 0, 0, 0);
                            acc[s_][ts] = __builtin_amdgcn_mfma_f32_16x16x32_bf16(wl, xh[ts], acc[s_][ts], 0, 0, 0);
                        }
                    }
                }
            }
            __syncthreads();
        }
        int e1[2], e2[2]; unsigned r1[2] = {0u, 0u}, r2[2] = {0u, 0u}; float w1[2], w2[2]; bool mine[2];
#pragma unroll
        for (int ts = 0; ts < 2; ++ts) {
            float sst = ssq[ts]; sst += __shfl_xor(sst, 16); sst += __shfl_xor(sst, 32);
            const float rstd = rsqrtf(sst * (1.f / 1024.f) + EPS);
            const float l0 = acc[2][ts][0] * rstd + cj[32 + fq * 4 + 0], l1 = acc[2][ts][1] * rstd + cj[32 + fq * 4 + 1];
            const float l2 = acc[2][ts][2] * rstd + cj[32 + fq * 4 + 2], l3 = acc[2][ts][3] * rstd + cj[32 + fq * 4 + 3];
            int gi = 0; float gm = l0;
            if (l1 > gm) { gm = l1; gi = 1; }
            if (l2 > gm) { gm = l2; gi = 2; }
            if (l3 > gm) { gm = l3; gi = 3; }
            const float gs = __expf(l0 - gm) + __expf(l1 - gm) + __expf(l2 - gm) + __expf(l3 - gm);
            const float gw = 1.f / gs;
            float el[8];
#pragma unroll
            for (int j = 0; j < 4; ++j) { el[j] = acc[0][ts][j] * rstd + cj[fq * 4 + j]; el[4 + j] = acc[1][ts][j] * rstd + cj[16 + fq * 4 + j]; }
            int i1 = 0; float m1 = el[0];
#pragma unroll
            for (int i = 1; i < 8; ++i) if (el[i] > m1) { m1 = el[i]; i1 = i; }
            int i2 = -1; float m2 = -3.0e38f;
#pragma unroll
            for (int i = 0; i < 8; ++i) if (i != i1 && el[i] > m2) { m2 = el[i]; i2 = i; }
            const float ex = __expf(m2 - m1);
            const float p1 = 1.f / (1.f + ex), p2 = ex / (1.f + ex);
            mine[ts] = (fq == gi);
            e1[ts] = gi * 8 + i1; e2[ts] = gi * 8 + i2; w1[ts] = gw * p1; w2[ts] = gw * p2;
            if (mine[ts]) {
                r1[ts] = __hip_atomic_fetch_add(&lcnt[e1[ts]], 1u, __ATOMIC_RELAXED, __HIP_MEMORY_SCOPE_WORKGROUP);
                r2[ts] = __hip_atomic_fetch_add(&lcnt[e2[ts]], 1u, __ATOMIC_RELAXED, __HIP_MEMORY_SCOPE_WORKGROUP);
            }
        }
        __syncthreads();
        if (tid < 32) { const unsigned c = lcnt[tid]; lcnt[32 + tid] = c ? atomicAdd((unsigned*)(ws + WS_CTL) + CW_CNT + l * 32 + tid, c) : 0u; }
        __syncthreads();
#pragma unroll
        for (int ts = 0; ts < 2; ++ts) {
            if (mine[ts]) {
                const int t = blk * 256 + wave * 32 + ts * 16 + fr;
                int4* rt = (int4*)(ws + WS_ROUTE) + (size_t)t * 2;
                rt[0] = make_int4(e1[ts], (int)(lcnt[32 + e1[ts]] + r1[ts]), __float_as_int(w1[ts]), 0);
                rt[1] = make_int4(e2[ts], (int)(lcnt[32 + e2[ts]] + r2[ts]), __float_as_int(w2[ts]), 0);
            }
        }
        {
            float gs[16], sv[16];
            norm_consts(g2, mod + 3 * 1024, mod + 4 * 1024, b, lane, gs, sv);
            unsigned char* H = ws + WS_H;
#pragma unroll 1
            for (int r = 0; r < 32; r += 4) {
                const int t = blk * 256 + wave * 32 + r;
                float xq[4][16];
#pragma unroll
                for (int q = 0; q < 4; ++q)
#pragma unroll
                    for (int i = 0; i < 4; ++i) { const u32x2 v = *(const u32x2*)(x + (size_t)(t + q) * 1024 + i * 256 + lane * 4); xq[q][i * 4] = lo2f(v[0]); xq[q][i * 4 + 1] = hi2f(v[0]); xq[q][i * 4 + 2] = lo2f(v[1]); xq[q][i * 4 + 3] = hi2f(v[1]); }
#pragma unroll
                for (int q = 0; q < 4; ++q) norm_store_row_f8(H + (size_t)(t + q) * 1024, lane, xq[q], gs, sv);
            }
        }
        __syncthreads();
    }
}

constexpr bool G_SP2 = true, G_ALIGN = true;
constexpr int G_HTB = 128 * 64 * 2, G_STAGE_BYTES = 8 * G_HTB;
constexpr int LDS_POFF = G_STAGE_BYTES;
DEVINL int g_lds_byte(int r, int c) { const int st = (r >> 4) * 2 + (c >> 5), rr = r & 15, cc = c & 31, ob = rr * 64 + cc * 2; return st * 1024 + (ob ^ (((ob >> 9) & 1) << 5)); }
DEVINL void g_stage_rc(int b, int& R, int& C) { const int st = b / 1024, sb = b % 1024, swz = sb ^ (((sb >> 9) & 1) << 5); R = (st >> 1) * 16 + swz / 64; C = (st & 1) * 32 + (swz % 64) / 2; }
struct GUnit { const char* a; const char* b; int pm, pn, sub; };
DEVINL void g_tile_order(int L, int nM, int nN, int& pm, int& pn) {
    const int nwg = nM * nN; int wgid = L;
    { const int q = nwg / 8, r = nwg % 8, xcd = wgid % 8, off = wgid / 8; wgid = (xcd < r ? xcd * (q + 1) : r * (q + 1) + (xcd - r) * q) + off; }
    const int nig = 8 * nN, gid = wgid / nig, fm = gid * 8, gsz = (nM - fm) < 8 ? (nM - fm) : 8;
    pm = fm + ((wgid % nig) % gsz); pn = (wgid % nig) / gsz;
}
struct DenseSched {
    const char* A; const char* B; int lda, ldb, nM, nN; unsigned long long pnmap;
    DEVINL bool next(int i, GUnit& u) const {
        const int L = i * (int)gridDim.x + BID(); if (L >= nM * nN) return false;
        g_tile_order(L, nM, nN, u.pm, u.pn); u.sub = 0;
        if (pnmap) u.pn = (int)((pnmap >> (4 * u.pn)) & 15ull);
        u.a = A + (size_t)u.pm * 256 * lda * 2; u.b = B + (size_t)u.pn * 256 * ldb * 2; return true;
    }
};
struct SplitSched {
    const char* A; const char* A2; const char* B; int lda, ldb, nM, nN, pm_split;
    DEVINL bool next(int i, GUnit& u) const {
        const int L = i * (int)gridDim.x + BID(); if (L >= nM * nN) return false;
        g_tile_order(L, nM, nN, u.pm, u.pn); u.sub = 0;
        u.a = (u.pm < pm_split ? A + (size_t)u.pm * 256 * lda * 2 : A2 + (size_t)(u.pm - pm_split) * 256 * lda * 2); u.b = B + (size_t)u.pn * 256 * ldb * 2; return true;
    }
};
struct MoeSched {
    const char* A; const char* B; int lda, ldb; size_t bstride; LAS const int* poff;
    DEVINL bool next(int i, GUnit& u) const {
        const int L = i * (int)gridDim.x + BID(); const int ntm = __builtin_amdgcn_readfirstlane(poff[32]) >> 8; if (L >= ntm * 4) return false;
        u.pm = L >> 2; u.pn = L & 3; const int m0 = u.pm << 8; int e = 0;
        for (int q = 1; q < 32; ++q) { const int pq = __builtin_amdgcn_readfirstlane(poff[q]); if (m0 >= pq) e = q; }
        u.sub = e; u.a = A + (size_t)u.pm * 256 * lda * 2; u.b = B + (size_t)e * bstride + (size_t)u.pn * 256 * ldb * 2; return true;
    }
};
struct MoeGatherSched {
    const char* A; const char* B; int ldb; size_t bstride; LAS const int* poff; const int* tokl;
    DEVINL int tok(int row) const { return tokl[row]; }
    DEVINL bool next(int i, GUnit& u) const {
        const int L = i * (int)gridDim.x + BID(); const int ntm = __builtin_amdgcn_readfirstlane(poff[32]) >> 8; if (L >= ntm * 4) return false;
        u.pm = L >> 2; u.pn = L & 3; const int m0 = u.pm << 8; int e = 0;
        for (int q = 1; q < 32; ++q) { const int pq = __builtin_amdgcn_readfirstlane(poff[q]); if (m0 >= pq) e = q; }
        u.sub = e; u.a = A; u.b = B + (size_t)e * bstride + (size_t)u.pn * 256 * ldb * 2; return true;
    }
};
struct BranchSched {
    const char* Y0; const char* Y1; const char* Y2; const char* B;
    DEVINL bool next(int i, GUnit& u) const {
        const int tile = (i / 3) * (int)gridDim.x + BID(); if (tile >= 1024) return false;
        u.sub = i % 3; g_tile_order(tile, 256, 4, u.pm, u.pn);
        const char* y = u.sub == 0 ? Y0 : (u.sub == 1 ? Y1 : Y2);
        u.a = y + (size_t)u.pm * 256 * 512 * 2; u.b = B + (size_t)u.sub * 1024 * 512 * 2 + (size_t)u.pn * 256 * 512 * 2; return true;
    }
};

template <bool TR, bool GATHER, bool SP2, bool ALIGN, bool F8, class Sched, class Epi>
DEVINL void gemm_phase_t(LAS unsigned char* lds, const Sched& S, const Epi& E, int lda, int ldb, int K) {
    const int tid = TID(), wid = __builtin_amdgcn_readfirstlane(tid >> 6), lane = tid & 63, wr = wid >> 2, wc = wid & 3, fr = lane & 15, fq = lane >> 4;
    const int nt = K / 64;
    unsigned voffA[2], voffB[2];
#pragma unroll
    for (int i = 0; i < 2; ++i) { int R, C; g_stage_rc(tid * 16 + i * 8192, R, C);
        const int Ra = TR ? ((R & ~31) + 8 * ((R & 15) >> 2) + 4 * ((R >> 4) & 1) + (R & 3)) : R;
        voffA[i] = (unsigned)(Ra * lda + C) * 2u; voffB[i] = (unsigned)(R * ldb + C) * 2u; }
    const size_t kstep = 128, hstepA = GATHER ? 0 : (size_t)128 * lda * 2, hstepB = (size_t)128 * ldb * 2;
    unsigned gA[2][2] = {{0u, 0u}, {0u, 0u}}, gN[2][2] = {{0u, 0u}, {0u, 0u}};
#define PG8_TOK(dst, un) do { if constexpr (GATHER) { _Pragma("unroll") for (int h_ = 0; h_ < 2; ++h_) _Pragma("unroll") for (int i_ = 0; i_ < 2; ++i_) { int R_, C_; g_stage_rc(tid * 16 + i_ * 8192, R_, C_); \
        dst[h_][i_] = ((unsigned)S.tok((un).pm * 256 + h_ * 128 + R_) * (unsigned)lda + (unsigned)C_) * 2u; } } } while (0)
#define VA0(nx) (GATHER ? ((nx) ? gN[0] : gA[0]) : voffA)
#define VA1(nx) (GATHER ? ((nx) ? gN[1] : gA[1]) : voffA)
    const unsigned ldsw = (unsigned)wid * 1024u;
    const int aoff = g_lds_byte(wr * 64 + fr, fq * 8), boff = g_lds_byte(wc * 32 + fr, fq * 8);
#define PG8_SA(b, h) (((b) * 2 + (h)) * G_HTB)
#define PG8_SB(b, h) ((4 + (b) * 2 + (h)) * G_HTB)
#define PG8_STAGE(bufoff, gbase, voff) do { _Pragma("unroll") for (int _i = 0; _i < 2; ++_i) \
        __builtin_amdgcn_global_load_lds((const unsigned*)((const char*)(gbase) + (voff)[_i]), (LAS unsigned*)(lds + (bufoff) + ldsw + _i * 8192), 16, 0, 0); } while (0)
#define PG8_LDA(dst, b, h) do { if constexpr (F8) { _Pragma("unroll") for (int m = 0; m < 4; ++m) { const v4i lo_ = *(const LAS v4i*)(lds + PG8_SA(b, h) + aoff + m * 2048), hi_ = *(const LAS v4i*)(lds + PG8_SA(b, h) + aoff + m * 2048 + 1024); \
        dst##8[m] = __builtin_shufflevector(lo_, hi_, 0, 1, 2, 3, 4, 5, 6, 7); } } else { _Pragma("unroll") for (int m = 0; m < 4; ++m) _Pragma("unroll") for (int k = 0; k < 2; ++k) dst[m][k] = *(const LAS bf16x8*)(lds + PG8_SA(b, h) + aoff + m * 2048 + k * 1024); } } while (0)
#define PG8_LDB(dst, b, h) do { if constexpr (F8) { _Pragma("unroll") for (int n = 0; n < 2; ++n) { const v4i lo_ = *(const LAS v4i*)(lds + PG8_SB(b, h) + boff + n * 2048), hi_ = *(const LAS v4i*)(lds + PG8_SB(b, h) + boff + n * 2048 + 1024); \
        dst##8[n] = __builtin_shufflevector(lo_, hi_, 0, 1, 2, 3, 4, 5, 6, 7); } } else { _Pragma("unroll") for (int n = 0; n < 2; ++n) _Pragma("unroll") for (int k = 0; k < 2; ++k) dst[n][k] = *(const LAS bf16x8*)(lds + PG8_SB(b, h) + boff + n * 2048 + k * 1024); } } while (0)
#define PG8_MMA(ai, bj, At, Bt) do { __builtin_amdgcn_s_setprio(1); if constexpr (F8) { _Pragma("unroll") for (int m = 0; m < 4; ++m) _Pragma("unroll") for (int n = 0; n < 2; ++n) \
        asm volatile("v_mfma_f32_16x16x128_f8f6f4 %0, %1, %2, %0" : "+v"(acc[ai][bj][m][n]) : "v"(Bt##8[n]), "v"(At##8[m])); } else \
        _Pragma("unroll") for (int m = 0; m < 4; ++m) _Pragma("unroll") for (int n = 0; n < 2; ++n) _Pragma("unroll") for (int k = 0; k < 2; ++k) \
        acc[ai][bj][m][n] = TR ? __builtin_amdgcn_mfma_f32_16x16x32_bf16(At[m][k], Bt[n][k], acc[ai][bj][m][n], 0, 0, 0) : __builtin_amdgcn_mfma_f32_16x16x32_bf16(Bt[n][k], At[m][k], acc[ai][bj][m][n], 0, 0, 0); __builtin_amdgcn_s_setprio(0); } while (0)
#define PG8_WAIT_V(n) asm volatile("s_waitcnt vmcnt(" #n ")" ::: "memory")
#define PG8_WAIT_L(n) asm volatile("s_waitcnt lgkmcnt(" #n ")" ::: "memory")
#define PG8_BAR __builtin_amdgcn_s_barrier()
#define PG8_SCHED __builtin_amdgcn_sched_barrier(0)
    GUnit cur, nxt; int ui = 0;
    if (!S.next(0, cur)) return;
    f32x4 acc[2][2][4][2];
#pragma unroll
    for (int a = 0; a < 2; ++a)
#pragma unroll
        for (int b = 0; b < 2; ++b)
#pragma unroll
            for (int m = 0; m < 4; ++m)
#pragma unroll
                for (int n = 0; n < 2; ++n) acc[a][b][m][n] = (f32x4){0.f, 0.f, 0.f, 0.f};
    bf16x8 At[4][2], B0[2][2], B1[2][2];
    v8i At8[4], B08[2], B18[2];
    const char* cA = cur.a; const char* cB = cur.b;
    PG8_TOK(gA, cur);
    if constexpr (SP2) {
        PG8_STAGE(PG8_SB(0, 0), cB, voffB); PG8_STAGE(PG8_SB(0, 1), cB + hstepB, voffB); PG8_STAGE(PG8_SA(0, 0), cA, VA0(false)); PG8_STAGE(PG8_SA(0, 1), cA + hstepA, VA1(false));
        if (wr == 1) PG8_BAR;
        PG8_WAIT_V(2); PG8_BAR;
        PG8_STAGE(PG8_SB(1, 0), cB + kstep, voffB); PG8_STAGE(PG8_SA(1, 0), cA + kstep, VA0(false)); PG8_STAGE(PG8_SB(1, 1), cB + hstepB + kstep, voffB);
        PG8_WAIT_V(6); PG8_BAR;
    } else {
    PG8_STAGE(PG8_SB(0, 0), cB, voffB); PG8_STAGE(PG8_SA(0, 0), cA, VA0(false)); PG8_STAGE(PG8_SB(0, 1), cB + hstepB, voffB); PG8_STAGE(PG8_SA(0, 1), cA + hstepA, VA1(false));
    if (wr == 1) PG8_BAR;
    PG8_WAIT_V(4); PG8_BAR;
    PG8_STAGE(PG8_SB(1, 0), cB + kstep, voffB); PG8_STAGE(PG8_SA(1, 0), cA + kstep, VA0(false)); PG8_STAGE(PG8_SB(1, 1), cB + hstepB + kstep, voffB);
    PG8_WAIT_V(6); PG8_BAR;
    }
    for (;;) {
        const bool has_next = S.next(ui + 1, nxt);
        const char* nA = has_next ? nxt.a : cA; const char* nB = has_next ? nxt.b : cB;
        if (GATHER) { if (has_next) PG8_TOK(gN, nxt); else { gN[0][0] = gA[0][0]; gN[0][1] = gA[0][1]; gN[1][0] = gA[1][0]; gN[1][1] = gA[1][1]; } }
#pragma unroll 1
        for (int t = 0; t < nt; t += 2) {
            const bool last = (t == nt - 2);
            const char* a1 = cA + (size_t)(t + 1) * kstep;
            const char* a2 = last ? nA : cA + (size_t)(t + 2) * kstep; const char* b2 = last ? nB : cB + (size_t)(t + 2) * kstep;
            const char* a3 = a2 + kstep; const char* b3 = b2 + kstep;
            if constexpr (SP2) {
            PG8_LDB(B0, 0, 0); PG8_LDB(B1, 0, 1); PG8_SCHED; PG8_LDA(At, 0, 0); PG8_STAGE(PG8_SA(1, 1), a1 + hstepA, VA1(false));
            PG8_WAIT_V(8); PG8_WAIT_L(0); PG8_BAR; PG8_MMA(0, 0, At, B0); PG8_MMA(0, 1, At, B1); PG8_BAR; PG8_SCHED;
            PG8_LDA(At, 0, 1); PG8_STAGE(PG8_SB(0, 0), b2, voffB); PG8_STAGE(PG8_SB(0, 1), b2 + hstepB, voffB); PG8_STAGE(PG8_SA(0, 0), a2, VA0(last));
            PG8_WAIT_V(8); PG8_WAIT_L(0); PG8_BAR; PG8_MMA(1, 0, At, B0); PG8_MMA(1, 1, At, B1); PG8_BAR; PG8_SCHED;
            PG8_LDB(B0, 1, 0); PG8_LDB(B1, 1, 1); PG8_SCHED; PG8_LDA(At, 1, 0); PG8_STAGE(PG8_SA(0, 1), a2 + hstepA, VA1(last));
            PG8_WAIT_V(8); PG8_WAIT_L(0); PG8_BAR; PG8_MMA(0, 0, At, B0); PG8_MMA(0, 1, At, B1); PG8_BAR; PG8_SCHED;
            PG8_LDA(At, 1, 1); PG8_STAGE(PG8_SB(1, 0), b3, voffB); PG8_STAGE(PG8_SB(1, 1), b3 + hstepB, voffB); PG8_STAGE(PG8_SA(1, 0), a3, VA0(last));
            PG8_WAIT_V(8); PG8_WAIT_L(0); PG8_BAR; PG8_MMA(1, 0, At, B0); PG8_MMA(1, 1, At, B1); PG8_BAR; PG8_SCHED;
            } else {
            PG8_LDB(B0, 0, 0); PG8_SCHED; PG8_LDA(At, 0, 0); PG8_STAGE(PG8_SA(1, 1), a1 + hstepA, VA1(false));
            PG8_WAIT_L(8); PG8_BAR; PG8_WAIT_L(0); PG8_MMA(0, 0, At, B0); PG8_BAR; PG8_SCHED;
            PG8_LDB(B1, 0, 1); PG8_STAGE(PG8_SB(0, 0), b2, voffB);
            PG8_BAR; PG8_WAIT_L(0); PG8_MMA(0, 1, At, B1); PG8_BAR;
            PG8_LDA(At, 0, 1); PG8_STAGE(PG8_SA(0, 0), a2, VA0(last));
            PG8_BAR; PG8_WAIT_L(0); PG8_MMA(1, 0, At, B0); PG8_BAR; PG8_SCHED;
            PG8_STAGE(PG8_SB(0, 1), b2 + hstepB, voffB);
            PG8_WAIT_V(6); PG8_BAR; PG8_MMA(1, 1, At, B1); PG8_BAR;
            PG8_LDB(B0, 1, 0); PG8_SCHED; PG8_LDA(At, 1, 0); PG8_STAGE(PG8_SA(0, 1), a2 + hstepA, VA1(last));
            PG8_WAIT_L(8); PG8_BAR; PG8_WAIT_L(0); PG8_MMA(0, 0, At, B0); PG8_BAR; PG8_SCHED;
            PG8_LDB(B1, 1, 1); PG8_STAGE(PG8_SB(1, 0), b3, voffB);
            PG8_BAR; PG8_WAIT_L(0); PG8_MMA(0, 1, At, B1); PG8_BAR;
            PG8_LDA(At, 1, 1); PG8_STAGE(PG8_SA(1, 0), a3, VA0(last));
            PG8_BAR; PG8_WAIT_L(0); PG8_MMA(1, 0, At, B0); PG8_BAR; PG8_SCHED;
            PG8_STAGE(PG8_SB(1, 1), b3 + hstepB, voffB);
            PG8_WAIT_V(6); PG8_BAR; PG8_MMA(1, 1, At, B1); PG8_BAR;
                    }
        }
        if constexpr (F8) asm volatile("s_nop 15\n\ts_nop 15" ::: "memory");
        if constexpr (ALIGN) { if (wr == 0) PG8_BAR; }
        E(acc, cur, wr, wc, fr, fq);
        if (!has_next) break;
        if (!E.keep(cur))
#pragma unroll
        for (int a = 0; a < 2; ++a)
#pragma unroll
            for (int b = 0; b < 2; ++b)
#pragma unroll
                for (int m = 0; m < 4; ++m)
#pragma unroll
                    for (int n = 0; n < 2; ++n) acc[a][b][m][n] = (f32x4){0.f, 0.f, 0.f, 0.f};
        cur = nxt; cA = nA; cB = nB; ++ui;
        if (GATHER) { gA[0][0] = gN[0][0]; gA[0][1] = gN[0][1]; gA[1][0] = gN[1][0]; gA[1][1] = gN[1][1]; }
        if constexpr (ALIGN) { if (wr == 1) PG8_BAR; }
    }
    PG8_WAIT_V(0);
    if constexpr (!ALIGN) { if (wr == 0) PG8_BAR; }
    PG8_BAR;
#undef PG8_TOK
#undef VA0
#undef VA1
#undef PG8_SA
#undef PG8_SB
#undef PG8_STAGE
#undef PG8_LDA
#undef PG8_LDB
#undef PG8_MMA
#undef PG8_WAIT_V
#undef PG8_WAIT_L
#undef PG8_BAR
#undef PG8_SCHED
}
template <class Sched, class Epi> DEVINL void gemm_phase(LAS unsigned char* lds, const Sched& S, const Epi& E, int lda, int ldb, int K) { gemm_phase_t<false, false, G_SP2, G_ALIGN, false>(lds, S, E, lda, ldb, K); }
DEVINL void st4bf(u16* dst, f32x4 v) { u32x2 o = {pk2(v[0], v[1]), pk2(v[2], v[3])}; *(u32x2*)dst = o; }
DEVINL void st8bf(u16* dst, f32x4 a, f32x4 b) { u32x4 o = {pk2(a[0], a[1]), pk2(a[2], a[3]), pk2(b[0], b[1]), pk2(b[2], b[3])}; *(u32x4*)dst = o; }
typedef f32x4 GAcc[2][2][4][2];
#define G_ROW(u, ai, m) ((u).pm * 256 + (ai) * 128 + wr * 64 + (m) * 16 + fr)
#define G_RUN(u, bj) ((u).pn * 256 + (bj) * 128 + wc * 32)

struct EpiProj {
    unsigned char* ws;
    DEVINL bool keep(const GUnit&) const { return false; }
    DEVINL void operator()(const GAcc& acc, const GUnit& u, int wr, int wc, int fr, int fq) const {
#pragma unroll
        for (int bj = 0; bj < 2; ++bj) {
            const int cb = G_RUN(u, bj);
            u16* dst; int ld, c0;
            if (cb < 512) { dst = (u16*)(ws + WS_RQK); ld = 512; c0 = cb; }
            else if (cb < 1024) { dst = (u16*)(ws + WS_RV); ld = 512; c0 = cb - 512; }
            else if (cb < 1536) { dst = (u16*)(ws + WS_RG); ld = 512; c0 = cb - 1024; }
            else if (cb < 2048) { dst = (u16*)(ws + WS_FQ); ld = 512; c0 = cb - 1536; }
            else if (cb < 2560) { dst = (u16*)(ws + WS_FK); ld = 512; c0 = cb - 2048; }
            else if (cb < 3072) { dst = (u16*)(ws + WS_FV); ld = 512; c0 = cb - 2560; }
            else if (cb < 3328) { dst = (u16*)(ws + WS_MQ); ld = 256; c0 = cb - 3072; }
            else if (cb < 3456) { dst = (u16*)(ws + WS_MKV); ld = 128; c0 = cb - 3328; }
            else if (cb < 3520) { dst = (u16*)(ws + WS_KPE); ld = 64; c0 = cb - 3456; }
            else { dst = nullptr; ld = 0; c0 = 0; }
            const bool roped = (cb < 512) || (cb >= 3456 && cb < 3520);
            if (dst && roped) {
                const int g = (cb >> 5) & 1, hb = c0 & ~63, i0 = 16 * g + 4 * fq;
                const float2* tab = (const float2*)(ws + WS_ROPE);
#pragma unroll
                for (int ai = 0; ai < 2; ++ai)
#pragma unroll
                    for (int m = 0; m < 4; ++m) {
                        int row = G_ROW(u, ai, m); asm volatile("" : "+v"(row));
                        const float4 t0 = *(const float4*)(tab + (size_t)row * 32 + i0), t1 = *(const float4*)(tab + (size_t)row * 32 + i0 + 2);
                        const f32x4 x1 = acc[ai][bj][m][0], x2 = acc[ai][bj][m][1];
                        f32x4 y1, y2;
                        y1[0] = x1[0] * t0.x - x2[0] * t0.y; y2[0] = x2[0] * t0.x + x1[0] * t0.y;
                        y1[1] = x1[1] * t0.z - x2[1] * t0.w; y2[1] = x2[1] * t0.z + x1[1] * t0.w;
                        y1[2] = x1[2] * t1.x - x2[2] * t1.y; y2[2] = x2[2] * t1.x + x1[2] * t1.y;
                        y1[3] = x1[3] * t1.z - x2[3] * t1.w; y2[3] = x2[3] * t1.z + x1[3] * t1.w;
                        u16* rp = dst + (size_t)row * ld + hb + i0;
                        st4bf(rp, y1); st4bf(rp + 32, y2);
                        asm volatile("" ::: "memory");
                    }
            } else if (dst) {
#pragma unroll
                for (int ai = 0; ai < 2; ++ai)
#pragma unroll
                    for (int m = 0; m < 4; ++m) {
                        st8bf(dst + (size_t)G_ROW(u, ai, m) * ld + c0 + fq * 8, acc[ai][bj][m][0], acc[ai][bj][m][1]);
                    }
            } else if (cb == 3520 && fq == 0) {
                float* ffl = (float*)(ws + WS_FFL);
#pragma unroll
                for (int ai = 0; ai < 2; ++ai)
#pragma unroll
                    for (int m = 0; m < 4; ++m) *(f32x4*)(ffl + (size_t)G_ROW(u, ai, m) * 4) = acc[ai][bj][m][0];
            }
        }
    }
};
struct EpiVT { u16* dst; int col0; u16* dst2; int col2; int pn_split;
    DEVINL bool keep(const GUnit&) const { return false; }
    DEVINL void operator()(const GAcc& acc, const GUnit& u, int wr, int wc, int fr, int fq) const {
        const int b = u.pm >> 4, s0 = (u.pm & 15) * 256;
        u16* d = u.pn >= pn_split ? dst2 : dst; const int c0 = u.pn >= pn_split ? col2 : col0;
#pragma unroll
        for (int bj = 0; bj < 2; ++bj)
#pragma unroll
            for (int n = 0; n < 2; ++n) {
                const int eg = u.pn * 256 + bj * 128 + wc * 32 + n * 16 + fr - c0;
                u16* rp = d + ((size_t)(b * 4 + (eg >> 7)) * 128 + (eg & 127)) * 4096 + s0 + wr * 64 + fq * 8;
#pragma unroll
                for (int ai = 0; ai < 2; ++ai)
#pragma unroll
                    for (int g = 0; g < 2; ++g) st8bf(rp + ai * 128 + g * 32, acc[ai][bj][2 * g][n], acc[ai][bj][2 * g + 1][n]);
            }
    }
};
DEVINL void ph_gemm_in(const Params& p, LAS unsigned char* lds) {
    unsigned char* ws = WSP(p);
    { DenseSched SV{(const char*)(ws + WS_H), (const char*)(ws + WS_WIN), 1024, 1024, 256, 4, 0xBA32ull};
      gemm_phase_t<true, false, G_SP2, G_ALIGN, false>(lds, SV, EpiVT{(u16*)(ws + WS_RV), 512, (u16*)(ws + WS_FV), 2560, 8}, 1024, 1024, 1024); }
    DenseSched S{(const char*)(ws + WS_H), (const char*)(ws + WS_WIN), 1024, 1024, 256, 10, 0xDC98765410ull};
    gemm_phase(lds, S, EpiProj{ws}, 1024, 1024, 1024);
}
struct EpiStore { unsigned char* dst;
    DEVINL bool keep(const GUnit&) const { return false; }
    DEVINL void operator()(const GAcc& acc, const GUnit& u, int wr, int wc, int fr, int fq) const {
#pragma unroll
        for (int ai = 0; ai < 2; ++ai)
#pragma unroll
            for (int m = 0; m < 4; ++m)
#pragma unroll
                for (int bj = 0; bj < 2; ++bj) {
                    const int cb = G_RUN(u, bj), hh = cb >> 7, dc = (cb >> 5) & 3;
                    const f32x4 a0 = acc[ai][bj][m][0], a1 = acc[ai][bj][m][1];
                    const u32x2 o = {pk4_f8(a0[0], a0[1], a0[2], a0[3]), pk4_f8(a1[0], a1[1], a1[2], a1[3])};
                    *(u32x2*)(dst + (size_t)G_ROW(u, ai, m) * 512 + hh * 128 + (dc >> 1) * 64 + fq * 16 + (dc & 1) * 8) = o;
                }
    }
};
template <int W>
DEVINL void rmsnorm_inplace(u16* buf, const float* g) {
    const int lane = TID() & 63, gw = blockIdx.x * 8 + (TID() >> 6), GW = gridDim.x * 8;
    constexpr int PER = W / 64;
    float gl[PER];
#pragma unroll
    for (int i = 0; i < PER; ++i) gl[i] = g[lane * PER + i];
    for (int t = gw * 4; t < T_; t += GW * 4) {
        float v[4][PER];
#pragma unroll
        for (int q = 0; q < 4; ++q) {
            const u16* r = buf + (size_t)(t + q) * W + lane * PER;
            if constexpr (PER == 4) { const u32x2 w = *(const u32x2*)r; v[q][0] = lo2f(w[0]); v[q][1] = hi2f(w[0]); v[q][2] = lo2f(w[1]); v[q][3] = hi2f(w[1]); }
            else { const unsigned w = *(const unsigned*)r; v[q][0] = lo2f(w); v[q][1] = hi2f(w); }
        }
#pragma unroll
        for (int q = 0; q < 4; ++q) {
            float ss = 0.f;
#pragma unroll
            for (int i = 0; i < PER; ++i) ss += v[q][i] * v[q][i];
            ss = wsum(ss);
            const float rstd = rsqrtf(ss * (1.f / W) + EPS);
            u16* r = buf + (size_t)(t + q) * W + lane * PER;
            if constexpr (PER == 4) { const u32x2 o = {pk2(v[q][0] * rstd * gl[0], v[q][1] * rstd * gl[1]), pk2(v[q][2] * rstd * gl[2], v[q][3] * rstd * gl[3])}; *(u32x2*)r = o; }
            else *(unsigned*)r = pk2(v[q][0] * rstd * gl[0], v[q][1] * rstd * gl[1]);
        }
    }
}
DEVINL void ph_fcum(const Params& p, int l, LAS unsigned char* lds) {
    const int tid = TID(), lane = tid & 63, wave = tid >> 6;
    const float* ffl = (const float*)(WSP(p) + WS_FFL);
    float* fc = (float*)(WSP(p) + WS_FCUM);
    LAS float* wt = (LAS float*)lds;
    for (int bh = blockIdx.x; bh < 64; bh += gridDim.x) {
        const int b = bh >> 2, h = bh & 3;
        const float fb = p.in[I_FOXFB][l * 4 + h];
        float x[8], vals[8];
#pragma unroll
        for (int c = 0; c < 8; ++c) x[c] = ffl[((size_t)b * 4096 + (wave * 8 + c) * 64 + lane) * 4 + h] + fb;
        float carry = 0.f;
#pragma unroll
        for (int c = 0; c < 8; ++c) {
            float v = fminf(x[c], 0.f) - log1pf(__expf(-fabsf(x[c])));
#pragma unroll
            for (int o = 1; o < 64; o <<= 1) { const float n = __shfl_up(v, o); if (lane >= o) v += n; }
            vals[c] = carry + v;
            carry += __shfl(v, 63);
        }
        __syncthreads();
        if (lane == 0) wt[wave] = carry;
        __syncthreads();
        float off = 0.f;
        for (int w2 = 0; w2 < wave; ++w2) off += wt[w2];
#pragma unroll
        for (int c = 0; c < 8; ++c) fc[(size_t)bh * 4096 + (wave * 8 + c) * 64 + lane] = off + vals[c];
    }
}

DEVINL void retention_unit(const Params& p, LAS unsigned char* lds, const int bh) {
    unsigned char* ws = WSP(p);
    const int tid = TID(), lane = tid & 63, wave = __builtin_amdgcn_readfirstlane(tid >> 6), fr_ = lane & 15, fq_ = lane >> 4;
    constexpr int KIMG = 0, KTIMG = 16384, VTIMG = 32768, STIMG = 65536;
    const u16* RQK = (const u16*)(ws + WS_RQK); const u16* RVT = (const u16*)(ws + WS_RVT); u16* RG = (u16*)(ws + WS_RG);
    const int st_ = tid >> 2;
    const int skc = (tid & 3) * 2, svc = (tid & 3) * 4;
    const int qloc = wave * 16 + fr_;
    const int ncc = (wave >> 1) + 1;
    {
        const int b = bh >> 2, h = bh & 3;
        const float lg = (h == 0) ? -0.04580368961312479f : (h == 1) ? -0.02272007650008353f : (h == 2) ? -0.011315313227834146f : -0.005646563141142063f;
        const float g128 = __builtin_amdgcn_exp2f(128.f * lg);
        const float kfac = __builtin_amdgcn_exp2f((float)(127 - st_) * lg) * 0.125f;
        const float qdec = __builtin_amdgcn_exp2f((float)(qloc + 1) * lg);
        f32x4 S[4];
#pragma unroll
        for (int dt = 0; dt < 4; ++dt) S[dt] = f32x4{0.f, 0.f, 0.f, 0.f};
        for (int i = tid; i < 16384 / 16; i += NTHR) *(LAS u32x4*)(lds + STIMG + i * 16) = u32x4{0u, 0u, 0u, 0u};
        const size_t seq0 = (size_t)b * 4096;
        bf16x8 kreg[2], vreg[4], qf[2];
#define RET_LOAD(n_) do { const size_t r_ = seq0 + (size_t)(n_) * 128; \
            _Pragma("unroll") for (int i = 0; i < 2; ++i) kreg[i] = *(const bf16x8*)(RQK + (r_ + st_) * 512 + 256 + h * 64 + (skc + i) * 8); \
            _Pragma("unroll") for (int i = 0; i < 4; ++i) vreg[i] = *(const bf16x8*)(RVT + ((size_t)bh * 128 + st_) * 4096 + (size_t)(n_) * 128 + (svc + i) * 8); \
            _Pragma("unroll") for (int dc = 0; dc < 2; ++dc) qf[dc] = *(const bf16x8*)(RQK + (r_ + qloc) * 512 + h * 64 + dc * 32 + fq_ * 8); } while (0)
        RET_LOAD(0);
        for (int n = 0; n < 32; ++n) {
            const size_t row0 = seq0 + (size_t)n * 128;
            int st = st_, fr = fr_, fq = fq_;
            asm volatile("" : "+v"(st), "+v"(fr), "+v"(fq));
            const int lb0 = fr * 256 + ((fq ^ (fr & 3)) * 16);
            const int sb0 = fr * 128 + ((fq ^ ((fr >> 1) & 3)) * 16);
            const int kb0 = ((fr >> 2) * 8 + (fr & 3)) * 128 + ((fq ^ ((fr >> 1) & 3)) * 16);
            const int swzp = ((st >> 1) & 1) | (((st >> 3) & 3) << 1);
#pragma unroll
            for (int i = 0; i < 2; ++i) {
                const int c = skc + i;
                *(LAS bf16x8*)(lds + KIMG + st * 128 + ((c ^ swzp) * 16)) = kreg[i];
#pragma unroll
                for (int j = 0; j < 8; ++j) {
                    const int d = c * 8 + j;
                    *(LAS u16*)(lds + KTIMG + d * 256 + (((st >> 3) ^ (d & 15)) * 16) + (st & 7) * 2) = f2bf(kfac * bf2f((u16)kreg[i][j]));
                }
            }
#pragma unroll
            for (int i = 0; i < 4; ++i) {
                const int c = svc + i;
                *(LAS bf16x8*)(lds + VTIMG + st * 256 + ((c ^ (st & 15)) * 16)) = vreg[i];
            }
            const bf16x8 q0 = qf[0], q1 = qf[1];
            __syncthreads();
            if (n < 31) RET_LOAD(n + 1);
            bf16x8 pf[4];
#pragma unroll
            for (int cc = 0; cc < 4; ++cc) {
                if (cc < ncc) {
                    f32x4 s0 = f32x4{0.f, 0.f, 0.f, 0.f}, s1 = s0;
#pragma unroll
                    for (int dc = 0; dc < 2; ++dc) {
                        const int ka = kb0 + ((dc ^ (fr >> 3)) * 64);
                        const bf16x8 k0 = *(const LAS bf16x8*)(lds + ka + (KIMG + cc * 4096));
                        const bf16x8 k1 = *(const LAS bf16x8*)(lds + ka + (KIMG + cc * 4096 + 512));
                        s0 = __builtin_amdgcn_mfma_f32_16x16x32_bf16(k0, dc ? q1 : q0, s0, 0, 0, 0);
                        s1 = __builtin_amdgcn_mfma_f32_16x16x32_bf16(k1, dc ? q1 : q0, s1, 0, 0, 0);
                    }
                    float pv[8];
#pragma unroll
                    for (int jj = 0; jj < 4; ++jj) {
                        const int m0 = cc * 32 + fq * 8 + jj, m1 = m0 + 4;
                        pv[jj] = (m0 <= qloc) ? s0[jj] * 0.125f * __builtin_amdgcn_exp2f((float)(qloc - m0) * lg) : 0.f;
                        pv[4 + jj] = (m1 <= qloc) ? s1[jj] * 0.125f * __builtin_amdgcn_exp2f((float)(qloc - m1) * lg) : 0.f;
                    }
                    u32x4 w = {pk2(pv[0], pv[1]), pk2(pv[2], pv[3]), pk2(pv[4], pv[5]), pk2(pv[6], pv[7])};
                    pf[cc] = *reinterpret_cast<bf16x8*>(&w);
                }
            }
            f32x4 o[8];
#pragma unroll
            for (int et = 0; et < 8; ++et) {
                f32x4 a = f32x4{0.f, 0.f, 0.f, 0.f};
#pragma unroll
                for (int dc = 0; dc < 2; ++dc) {
                    const bf16x8 sf = *(const LAS bf16x8*)(lds + (sb0 + ((dc ^ (fr >> 3)) * 64)) + (STIMG + et * 2048));
                    a = __builtin_amdgcn_mfma_f32_16x16x32_bf16(sf, dc ? q1 : q0, a, 0, 0, 0);
                }
                a[0] *= qdec; a[1] *= qdec; a[2] *= qdec; a[3] *= qdec;
#pragma unroll
                for (int cc = 0; cc < 4; ++cc) {
                    if (cc < ncc) {
                        const bf16x8 vf = *(const LAS bf16x8*)(lds + (lb0 + ((cc ^ (fr >> 2)) * 64)) + (VTIMG + et * 4096));
                        a = __builtin_amdgcn_mfma_f32_16x16x32_bf16(vf, pf[cc], a, 0, 0, 0);
                    }
                }
                o[et] = a;
            }
#pragma unroll
            for (int dt = 0; dt < 4; ++dt) { S[dt][0] *= g128; S[dt][1] *= g128; S[dt][2] *= g128; S[dt][3] *= g128; }
#pragma unroll
            for (int cc = 0; cc < 4; ++cc) {
                const int la = lb0 + ((cc ^ (fr >> 2)) * 64);
                const bf16x8 vb = *(const LAS bf16x8*)(lds + la + wave * 4096 + VTIMG);
#pragma unroll
                for (int dt = 0; dt < 4; ++dt) {
                    const bf16x8 kt = *(const LAS bf16x8*)(lds + la + (KTIMG + dt * 4096));
                    S[dt] = __builtin_amdgcn_mfma_f32_16x16x32_bf16(kt, vb, S[dt], 0, 0, 0);
                }
            }
            __syncthreads();
            {
                const int e = wave * 16 + fr;
#pragma unroll
                for (int dt = 0; dt < 4; ++dt) {
                    u32x2 w = {pk2(S[dt][0], S[dt][1]), pk2(S[dt][2], S[dt][3])};
                    *(LAS u32x2*)(lds + STIMG + e * 128 + ((((dt * 2 + (fq >> 1)) ^ (e >> 1)) & 7) * 16) + (fq & 1) * 8) = w;
                }
            }
            float s1 = 0.f;
#pragma unroll
            for (int et = 0; et < 8; ++et) s1 += o[et][0] + o[et][1] + o[et][2] + o[et][3];
            s1 += __shfl_xor(s1, 16); s1 += __shfl_xor(s1, 32);
            const float mu = s1 * (1.f / 128.f);
            float s2 = 0.f;
#pragma unroll
            for (int et = 0; et < 8; ++et)
#pragma unroll
                for (int jj = 0; jj < 4; ++jj) { const float dlt = o[et][jj] - mu; s2 += dlt * dlt; }
            s2 += __shfl_xor(s2, 16); s2 += __shfl_xor(s2, 32);
            const float rs = rsqrtf(s2 * (1.f / 128.f) + EPS);
            u16* gp = RG + (row0 + qloc) * 512 + h * 128 + fq * 4;
#pragma unroll
            for (int et = 0; et < 8; ++et) {
                const u32x2 gv = *(const u32x2*)(gp + et * 16);
                f32x4 y;
                y[0] = siluf_(lo2f(gv[0])) * (o[et][0] - mu) * rs; y[1] = siluf_(hi2f(gv[0])) * (o[et][1] - mu) * rs;
                y[2] = siluf_(lo2f(gv[1])) * (o[et][2] - mu) * rs; y[3] = siluf_(hi2f(gv[1])) * (o[et][3] - mu) * rs;
                st4bf(gp + et * 16, y);
            }
        }
#undef RET_LOAD
        __syncthreads();
    }
}

DEVINL void ph_kmax(const Params& p, int l) {
    unsigned char* ws = WSP(p);
    const int lane = TID() & 63, gw = blockIdx.x * 8 + (TID() >> 6), GW = gridDim.x * 8;
    unsigned* kmax = (unsigned*)(ws + WS_CTL) + CW_KMAX + l * 64;
    for (int c = gw; c < 2048; c += GW) {
        const int bh = c >> 5, b = bh >> 2, h = bh & 3, s0 = (c & 31) * 128;
        float mx = 0.f;
#pragma unroll
        for (int q = 0; q < 2; ++q) {
            const u32x4* rp = (const u32x4*)((const u16*)(ws + WS_FK) + ((size_t)b * 4096 + s0 + q * 64 + lane) * 512 + h * 128);
            u32x4 v[16];
#pragma unroll
            for (int i = 0; i < 16; ++i) v[i] = rp[i];
            float ss = 0.f;
#pragma unroll
            for (int i = 0; i < 16; ++i)
#pragma unroll
                for (int e = 0; e < 4; ++e) { const float lo = lo2f(v[i][e]), hi = hi2f(v[i][e]); ss += lo * lo + hi * hi; }
            mx = fmaxf(mx, ss);
        }
        for (int o = 32; o; o >>= 1) mx = fmaxf(mx, __shfl_xor(mx, o));
        if (lane == 0) atomicMax(&kmax[bh], __float_as_uint(sqrtf(mx)));
    }
}

template <bool MLA>
DEVINL void attn_unit(const Params& p, LAS unsigned char* lds, int l, int bh, int qt) {
    unsigned char* ws = WSP(p);
    const int tid = TID(), lane = tid & 63, wave = __builtin_amdgcn_readfirstlane(tid >> 6), fr = lane & 15, fq = lane >> 4;
    const int b = bh >> 2, h = bh & 3, t0 = qt * 256, wrow0 = t0 + wave * 32;
    constexpr int DC = MLA ? 6 : 4;
    constexpr float L2E = 1.4426950408889634f;
    constexpr float C2 = (MLA ? 0.07216878364870323f : 0.08838834764831845f) * L2E;
    constexpr int BUF = 40960, VOTE_OFF = 122880;
    const size_t rowb = (size_t)b * 4096;
    const u16* Kg = (const u16*)(ws + (MLA ? WS_KN : WS_FK)) + rowb * 512 + h * 128;
    const int kld = 512;
    const unsigned char* K8g = ws + WS_KN + rowb * 512 + h * 128;
    const u16* KPg = (const u16*)(ws + WS_KPE) + rowb * 64;
    const u16* VTg = (const u16*)(ws + (MLA ? WS_MVT : WS_FVT)) + (size_t)bh * 128 * 4096;
    u16* Qg = MLA ? (u16*)(ws + WS_Q) + (rowb + wrow0) * 768 + h * 192 : (u16*)(ws + WS_FQ) + (rowb + wrow0) * 512 + h * 128;
    const int qld = MLA ? 768 : 512;
    u16* Og = MLA ? (u16*)(ws + WS_YC) + (rowb + wrow0) * 512 + h * 128 : Qg;
    const float* fc = (const float*)(ws + WS_FCUM) + (size_t)bh * 4096;

    bf16x8 qf[2][DC];
#pragma unroll
    for (int qs = 0; qs < 2; ++qs)
#pragma unroll
        for (int dc = 0; dc < DC; ++dc) qf[qs][dc] = *(const bf16x8*)(Qg + (size_t)(qs * 16 + fr) * qld + dc * 32 + fq * 8);
    v8i q8[2];
    if (MLA) {
#pragma unroll
        for (int qs = 0; qs < 2; ++qs) {
            unsigned w8[8];
#pragma unroll
            for (int dc = 0; dc < 4; ++dc) {
                const bf16x8 q = qf[qs][dc];
                w8[dc * 2] = pk4_f8(bf2f((u16)q[0]), bf2f((u16)q[1]), bf2f((u16)q[2]), bf2f((u16)q[3]));
                w8[dc * 2 + 1] = pk4_f8(bf2f((u16)q[4]), bf2f((u16)q[5]), bf2f((u16)q[6]), bf2f((u16)q[7]));
            }
            q8[qs] = v8i{(int)w8[0], (int)w8[1], (int)w8[2], (int)w8[3], (int)w8[4], (int)w8[5], (int)w8[6], (int)w8[7]};
        }
    }
    float Fq[2] = {0.f, 0.f}, qb[2] = {0.f, 0.f};
    if (!MLA) {
        const float kmx = __uint_as_float(((const unsigned*)(ws + WS_CTL))[CW_KMAX + l * 64 + bh]);
#pragma unroll
        for (int qs = 0; qs < 2; ++qs) {
            Fq[qs] = fc[wrow0 + qs * 16 + fr] * L2E;
            float ss = 0.f;
#pragma unroll
            for (int dc = 0; dc < 4; ++dc)
#pragma unroll
                for (int e = 0; e < 8; ++e) { const float v = bf2f((u16)qf[qs][dc][e]); ss += v * v; }
            ss += __shfl_xor(ss, 16); ss += __shfl_xor(ss, 32);
            qb[qs] = sqrtf(ss) * kmx * C2 * 1.0001f;
        }
    }
    float m[2] = {-1e30f, -1e30f}, lsum[2] = {0.f, 0.f};
    f32x4 o[2][8];
#pragma unroll
    for (int qs = 0; qs < 2; ++qs)
#pragma unroll
        for (int et = 0; et < 8; ++et) o[qs][et] = f32x4{0.f, 0.f, 0.f, 0.f};

    const int kr = tid >> 4, kc = tid & 15;
    const int swk0 = (kr & 3) | (((kr >> 3) & 3) << 2);
    const int wk0 = kr * 256 + ((kc ^ swk0) * 16);
    const int vr = tid >> 3, vc = tid & 7;
    const int wv0 = 16384 + vr * 128 + ((vc ^ ((vr >> 1) & 7)) * 16);
    const int wp = 32768 + vr * 128 + ((vc ^ (((vr >> 1) & 1) | (((vr >> 3) & 3) << 1))) * 16);
    const int rbase = (fr >> 2) * 8 + (fr & 3);
    int kb0 = rbase * 256 + ((fq ^ (fr & 3)) * 16) + ((fr >> 2) * 64);
    int kp0 = 32768 + rbase * 128 + ((((fq) ^ (fr >> 1)) & 7) * 16);
    int vb0 = 16384 + fr * 128 + ((fr >> 3) * 64) + ((fq ^ ((fr >> 1) & 3)) * 16);
    int k8b = rbase * 128 + ((fq ^ ((fr & 3) | (((fr >> 2) & 1) << 2))) * 16);

    bf16x8 stk0, stk1, stv0, stv1, stp;
#define LOADT(j_) do { const int s0_ = (j_) * 64; \
        if (MLA) stk0 = *(const bf16x8*)(K8g + (size_t)(s0_ + vr) * 512 + vc * 16); \
        else { stk0 = *(const bf16x8*)(Kg + (size_t)(s0_ + kr) * kld + kc * 8); stk1 = *(const bf16x8*)(Kg + (size_t)(s0_ + 32 + kr) * kld + kc * 8); } \
        stv0 = *(const bf16x8*)(VTg + (size_t)vr * 4096 + s0_ + vc * 8); stv1 = *(const bf16x8*)(VTg + (size_t)(vr + 64) * 4096 + s0_ + vc * 8); \
        if (MLA) stp = *(const bf16x8*)(KPg + (size_t)(s0_ + vr) * 64 + vc * 8); } while (0)
#define WRITET(bf_) do { LAS unsigned char* d_ = lds + (bf_) * BUF; int tl_ = tid; asm volatile("" : "+v"(tl_));     \
        const int kr_ = tl_ >> 4, kc_ = tl_ & 15, vr_ = tl_ >> 3, vc_ = tl_ & 7; \
        const int wk_ = kr_ * 256 + ((kc_ ^ ((kr_ & 3) | (((kr_ >> 3) & 3) << 2))) * 16), wv_ = 16384 + vr_ * 128 + ((vc_ ^ ((vr_ >> 1) & 7)) * 16); \
        if (MLA) *(LAS bf16x8*)(d_ + vr_ * 128 + ((vc_ ^ ((vr_ & 3) | (((vr_ >> 3) & 1) << 2))) * 16)) = stk0; \
        else { *(LAS bf16x8*)(d_ + wk_) = stk0; *(LAS bf16x8*)(d_ + wk_ + 8192) = stk1; } \
        *(LAS bf16x8*)(d_ + wv_) = stv0; *(LAS bf16x8*)(d_ + wv_ + 8192) = stv1; \
        if (MLA) *(LAS bf16x8*)(d_ + 32768 + vr_ * 128 + ((vc_ ^ (((vr_ >> 1) & 1) | (((vr_ >> 3) & 3) << 1))) * 16)) = stp; } while (0)

    const int jmax = qt * 4 + 3;
    LOADT(jmax); WRITET(0);
    __syncthreads();
    bf16x8 pfp[2][2]; bool pact = false;
    int cur = 0, prv = 2, nxt = 1;
    for (int j = jmax, it = 0;; --j, ++it) {
        LAS unsigned char* bufp = lds + cur * BUF;
        LAS unsigned char* bufq = lds + prv * BUF;
        if (j > 0) LOADT(j - 1);
        const bool act = (64 * j <= wrow0 + 31);
        asm volatile("" : "+v"(kb0), "+v"(kp0), "+v"(vb0), "+v"(k8b));
#define kbL kb0
#define kpL kp0
#define vbL vb0
        f32x4 sa[2][4];
        if (act) {
#pragma unroll
            for (int qs = 0; qs < 2; ++qs)
#pragma unroll
                for (int kt = 0; kt < 4; ++kt) sa[qs][kt] = f32x4{0.f, 0.f, 0.f, 0.f};
            __builtin_amdgcn_s_setprio(1);
            if constexpr (MLA) {
#pragma unroll
                for (int kt = 0; kt < 4; ++kt)
#pragma unroll
                    for (int dcp = 0; dcp < 2; ++dcp) {
                        const bf16x8 kf = *(LAS bf16x8*)(bufp + (kpL ^ (dcp << 6)) + (kt >> 1) * 4096 + (kt & 1) * 512);
                        sa[0][kt] = __builtin_amdgcn_mfma_f32_16x16x32_bf16(kf, qf[0][DC - 2 + dcp], sa[0][kt], 0, 0, 0);
                        sa[1][kt] = __builtin_amdgcn_mfma_f32_16x16x32_bf16(kf, qf[1][DC - 2 + dcp], sa[1][kt], 0, 0, 0);
                    }
                v8i k8[4];
#pragma unroll
                for (int kt = 0; kt < 4; ++kt) {
                    const v4i lo_ = *(const LAS v4i*)(bufp + k8b + (kt >> 1) * 4096 + (kt & 1) * 512), hi_ = *(const LAS v4i*)(bufp + (k8b ^ 64) + (kt >> 1) * 4096 + (kt & 1) * 512);
                    k8[kt] = __builtin_shufflevector(lo_, hi_, 0, 1, 2, 3, 4, 5, 6, 7);
                }
                asm volatile("s_nop 15" ::: "memory");
#pragma unroll
                for (int kt = 0; kt < 4; ++kt) {
                    asm volatile("v_mfma_f32_16x16x128_f8f6f4 %0, %1, %2, %0" : "+v"(sa[0][kt]) : "v"(k8[kt]), "v"(q8[0]));
                    asm volatile("v_mfma_f32_16x16x128_f8f6f4 %0, %1, %2, %0" : "+v"(sa[1][kt]) : "v"(k8[kt]), "v"(q8[1]));
                }
                asm volatile("s_nop 15\n\ts_nop 15" ::: "memory");
            } else {
#pragma unroll
            for (int kt = 0; kt < 4; ++kt) {
#pragma unroll
                for (int dc = 0; dc < 4; ++dc) {
                    const bf16x8 kf = *(LAS bf16x8*)(bufp + (kbL ^ (dc << 6)) + (kt >> 1) * 8192 + (kt & 1) * 1024);
                    sa[0][kt] = __builtin_amdgcn_mfma_f32_16x16x32_bf16(kf, qf[0][dc], sa[0][kt], 0, 0, 0);
                    sa[1][kt] = __builtin_amdgcn_mfma_f32_16x16x32_bf16(kf, qf[1][dc], sa[1][kt], 0, 0, 0);
                }
            }
            }
            __builtin_amdgcn_s_setprio(0);
        }
        if (pact) {
            __builtin_amdgcn_s_setprio(1);
#pragma unroll
            for (int c32 = 0; c32 < 2; ++c32)
#pragma unroll
                for (int et = 0; et < 8; ++et) {
                    const bf16x8 vf = *(LAS bf16x8*)(bufq + (vbL ^ (c32 << 6)) + et * 2048);
                    o[0][et] = __builtin_amdgcn_mfma_f32_16x16x32_bf16(vf, pfp[0][c32], o[0][et], 0, 0, 0);
                    o[1][et] = __builtin_amdgcn_mfma_f32_16x16x32_bf16(vf, pfp[1][c32], o[1][et], 0, 0, 0);
                }
            __builtin_amdgcn_s_setprio(0);
        }
        if (act) {
            float fkl[2][8];
            if (!MLA) {
#pragma unroll
                for (int c32 = 0; c32 < 2; ++c32) {
                    const float4 a = *(const float4*)(fc + 64 * j + c32 * 32 + fq * 8), c = *(const float4*)(fc + 64 * j + c32 * 32 + fq * 8 + 4);
                    fkl[c32][0] = a.x * L2E; fkl[c32][1] = a.y * L2E; fkl[c32][2] = a.z * L2E; fkl[c32][3] = a.w * L2E;
                    fkl[c32][4] = c.x * L2E; fkl[c32][5] = c.y * L2E; fkl[c32][6] = c.z * L2E; fkl[c32][7] = c.w * L2E;
                }
            }
            const bool needmask = (64 * j + 63 > wrow0);
            bf16x8 pf[2][2];
#pragma unroll
            for (int qs = 0; qs < 2; ++qs) {
                const int row = wrow0 + qs * 16 + fr;
                if (!MLA) {
#pragma unroll
                    for (int kt = 0; kt < 4; ++kt)
#pragma unroll
                        for (int jj = 0; jj < 4; ++jj) sa[qs][kt][jj] = fmaf(sa[qs][kt][jj], C2, Fq[qs] - fkl[kt >> 1][(kt & 1) * 4 + jj]);
                }
                if (needmask) {
#pragma unroll
                    for (int kt = 0; kt < 4; ++kt)
#pragma unroll
                        for (int jj = 0; jj < 4; ++jj) { const int key = 64 * j + (kt >> 1) * 32 + fq * 8 + (kt & 1) * 4 + jj; if (key > row) sa[qs][kt][jj] = -__builtin_inff(); }
                }
                float mx = sa[qs][0][0];
#pragma unroll
                for (int kt = 0; kt < 4; ++kt)
#pragma unroll
                    for (int jj = 0; jj < 4; ++jj) mx = fmaxf(mx, sa[qs][kt][jj]);
                mx = fmaxf(mx, __shfl_xor(mx, 16)); mx = fmaxf(mx, __shfl_xor(mx, 32));
                if (MLA) mx *= C2;
                const float mn = fmaxf(m[qs], mx);
                const float al = __builtin_amdgcn_exp2f(m[qs] - mn);
                m[qs] = mn;
                if (__any(al != 1.f)) {
#pragma unroll
                    for (int et = 0; et < 8; ++et) { o[qs][et][0] *= al; o[qs][et][1] *= al; o[qs][et][2] *= al; o[qs][et][3] *= al; }
                }
                float rs = 0.f;
#pragma unroll
                for (int kt = 0; kt < 4; ++kt)
#pragma unroll
                    for (int jj = 0; jj < 4; ++jj) {
                        const float pv = MLA ? __builtin_amdgcn_exp2f(fmaf(sa[qs][kt][jj], C2, -mn)) : __builtin_amdgcn_exp2f(sa[qs][kt][jj] - mn);
                        rs += pv; sa[qs][kt][jj] = pv;
                    }
                lsum[qs] = lsum[qs] * al + rs;
#pragma unroll
                for (int c32 = 0; c32 < 2; ++c32) {
                    u32x4 w = {pk2(sa[qs][2 * c32][0], sa[qs][2 * c32][1]), pk2(sa[qs][2 * c32][2], sa[qs][2 * c32][3]),
                               pk2(sa[qs][2 * c32 + 1][0], sa[qs][2 * c32 + 1][1]), pk2(sa[qs][2 * c32 + 1][2], sa[qs][2 * c32 + 1][3])};
                    pf[qs][c32] = *reinterpret_cast<bf16x8*>(&w);
                }
            }
            pfp[0][0] = pf[0][0]; pfp[0][1] = pf[0][1]; pfp[1][0] = pf[1][0]; pfp[1][1] = pf[1][1];
        }
        pact = act;
        if (j > 0) WRITET(nxt);
        bool stop = (j == 0);
        if (!MLA && !stop) {
            const float fk1 = fc[64 * j - 1] * L2E;
            const bool c0 = (qb[0] + Fq[0] - fk1 < m[0] - 151.5f), c1 = (qb[1] + Fq[1] - fk1 < m[1] - 151.5f);
            const bool wv = __all(c0 && c1);
            if (lane == 0) ((LAS unsigned*)(lds + VOTE_OFF))[(it & 1) * 8 + wave] = wv ? 1u : 0u;
        }
        __syncthreads();
        if (!MLA && !stop) {
            const u32x4 v0 = *(LAS u32x4*)(lds + VOTE_OFF + (it & 1) * 32), v1 = *(LAS u32x4*)(lds + VOTE_OFF + (it & 1) * 32 + 16);
            stop = (v0[0] & v0[1] & v0[2] & v0[3] & v1[0] & v1[1] & v1[2] & v1[3]) != 0u;
        }
        if (stop) break;
        prv = cur; cur = nxt; nxt = (nxt == 2) ? 0 : nxt + 1;
    }
    if (pact) {
        LAS unsigned char* bufq = lds + cur * BUF;
#pragma unroll
        for (int c32 = 0; c32 < 2; ++c32)
#pragma unroll
            for (int et = 0; et < 8; ++et) {
                const bf16x8 vf = *(LAS bf16x8*)(bufq + (vb0 ^ (c32 << 6)) + et * 2048);
                o[0][et] = __builtin_amdgcn_mfma_f32_16x16x32_bf16(vf, pfp[0][c32], o[0][et], 0, 0, 0);
                o[1][et] = __builtin_amdgcn_mfma_f32_16x16x32_bf16(vf, pfp[1][c32], o[1][et], 0, 0, 0);
            }
    }
#undef LOADT
#undef WRITET
#undef kbL
#undef kpL
#undef vbL
#pragma unroll
    for (int qs = 0; qs < 2; ++qs) {
        float lt = lsum[qs];
        lt += __shfl_xor(lt, 16); lt += __shfl_xor(lt, 32);
        const float inv = 1.f / lt;
        u16* orow = Og + (size_t)(qs * 16 + fr) * 512;
#pragma unroll
        for (int et = 0; et < 8; ++et) {
            f32x4 v = o[qs][et]; v[0] *= inv; v[1] *= inv; v[2] *= inv; v[3] *= inv;
            st4bf(orow + et * 16 + fq * 4, v);
        }
    }
}
constexpr int CW_QUEUE = 6144;
DEVINL void ph_mixers(const Params& p, int l, LAS unsigned char* lds) {
    unsigned* q = (unsigned*)(WSP(p) + WS_CTL) + CW_QUEUE + l * 64;
    LAS unsigned* slot = (LAS unsigned*)(lds + 123008);
    for (;;) {
        __syncthreads();
        if (TID() == 0) *slot = __hip_atomic_fetch_add(q, 1u, __ATOMIC_RELAXED, __HIP_MEMORY_SCOPE_AGENT);
        __syncthreads();
        const int it = (int)__builtin_amdgcn_readfirstlane(*slot);
        if (it >= 64 + 2048) break;
        if (it < 64) retention_unit(p, lds, it);
        else if (it < 64 + 1024) { const int i = it - 64; attn_unit<true>(p, lds, l, i & 63, 15 - (i >> 6)); }
        else { const int i = it - 1088; attn_unit<false>(p, lds, l, i & 63, 15 - (i >> 6)); }
    }
}

struct EpiQ { unsigned char* ws;
    DEVINL bool keep(const GUnit&) const { return false; }
    DEVINL void operator()(const GAcc& acc, const GUnit& u, int wr, int wc, int fr, int fq) const {
        u16* dst = (u16*)(ws + WS_Q);
        const float2* tab = (const float2*)(ws + WS_ROPE);
#pragma unroll
        for (int bj = 0; bj < 2; ++bj) {
            const int cb = G_RUN(u, bj), hh = cb / 192, w = cb - hh * 192;
            if (w >= 128) {
                const int g = (w - 128) >> 5, i0 = 16 * g + 4 * fq;
#pragma unroll
                for (int ai = 0; ai < 2; ++ai)
#pragma unroll
                    for (int m = 0; m < 4; ++m) {
                        int row = G_ROW(u, ai, m); asm volatile("" : "+v"(row));
                        const float4 t0 = *(const float4*)(tab + (size_t)row * 32 + i0), t1 = *(const float4*)(tab + (size_t)row * 32 + i0 + 2);
                        const f32x4 x1 = acc[ai][bj][m][0], x2 = acc[ai][bj][m][1];
                        f32x4 y1, y2;
                        y1[0] = x1[0] * t0.x - x2[0] * t0.y; y2[0] = x2[0] * t0.x + x1[0] * t0.y;
                        y1[1] = x1[1] * t0.z - x2[1] * t0.w; y2[1] = x2[1] * t0.z + x1[1] * t0.w;
                        y1[2] = x1[2] * t1.x - x2[2] * t1.y; y2[2] = x2[2] * t1.x + x1[2] * t1.y;
                        y1[3] = x1[3] * t1.z - x2[3] * t1.w; y2[3] = x2[3] * t1.z + x1[3] * t1.w;
                        u16* rp = dst + (size_t)row * 768 + hh * 192 + 128 + i0;
                        st4bf(rp, y1); st4bf(rp + 32, y2);
                        asm volatile("" ::: "memory");
                    }
            } else {
#pragma unroll
                for (int ai = 0; ai < 2; ++ai)
#pragma unroll
                    for (int m = 0; m < 4; ++m) {
                        st8bf(dst + (size_t)G_ROW(u, ai, m) * 768 + cb + fq * 8, acc[ai][bj][m][0], acc[ai][bj][m][1]);
                    }
            }
        }
    }
};
DEVINL void ph_gemm_mla_up(const Params& p, LAS unsigned char* lds) {
    unsigned char* ws = WSP(p);
    { DenseSched S{(const char*)(ws + WS_MQ), (const char*)(ws + WS_WQ), 256, 256, 256, 3, 0ull};
      gemm_phase_t<false, false, false, false, false>(lds, S, EpiQ{ws}, 256, 256, 256); }
    { DenseSched S{(const char*)(ws + WS_MKV), (const char*)(ws + WS_WKV), 128, 128, 256, 2, 0ull};
      gemm_phase_t<false, false, false, false, false>(lds, S, EpiStore{ws + WS_KN}, 128, 128, 128); }
    { DenseSched S{(const char*)(ws + WS_MKV), (const char*)(ws + WS_WKV), 128, 128, 256, 2, 0x32ull};
      gemm_phase_t<true, false, false, false, false>(lds, S, EpiVT{(u16*)(ws + WS_MVT), 512, (u16*)(ws + WS_MVT), 512, 99}, 128, 128, 128); }
}
struct EpiGate { unsigned char* ws; const float* bias;
    DEVINL bool keep(const GUnit&) const { return false; }
    DEVINL void operator()(const GAcc& acc, const GUnit& u, int wr, int wc, int fr, int fq) const {
        const int i = u.pn >> 2;
        unsigned char* dst = ws + (i == 0 ? WS_G0 : (i == 1 ? WS_G1 : WS_G2));
        const int cg = u.pn * 256 + wc * 64 + fq * 16, cl = cg & 1023;
        float bz[16];
#pragma unroll
        for (int q = 0; q < 4; ++q) { const float4 b4 = *(const float4*)(bias + cg + q * 4); bz[q * 4] = b4.x; bz[q * 4 + 1] = b4.y; bz[q * 4 + 2] = b4.z; bz[q * 4 + 3] = b4.w; }
        constexpr float R = 1.f / W8_SCALE;
#pragma unroll
        for (int ai = 0; ai < 2; ++ai)
#pragma unroll
            for (int m = 0; m < 4; ++m) {
                unsigned w[4];
#pragma unroll
                for (int bj = 0; bj < 2; ++bj)
#pragma unroll
                    for (int n = 0; n < 2; ++n) {
                        const f32x4 v = acc[ai][bj][m][n];
                        unsigned pk = 0u;
#pragma unroll
                        for (int j = 0; j < 4; ++j) pk = __builtin_amdgcn_cvt_pk_u8_f32(fmaxf(rintf(sigmoidf_(fmaf(v[j], R, bz[bj * 8 + n * 4 + j])) * 255.f), 1.f), j, pk);
                        w[bj * 2 + n] = pk;
                    }
                const u32x4 o = {w[0], w[1], w[2], w[3]};
                *(u32x4*)(dst + (size_t)G_ROW(u, ai, m) * 1024 + cl) = o;
            }
    }
};
DEVINL void ph_gates(const Params& p, int l, LAS unsigned char* lds) {
    unsigned char* ws = WSP(p);
    DenseSched S{(const char*)H8P(p), (const char*)(ws + WS_GATE), 512, 512, 256, 12, 0ull};
    gemm_phase_t<false, false, G_SP2, G_ALIGN, true>(lds, S, EpiGate{ws, p.in[I_GATEB] + (size_t)l * 3072}, 512, 512, 512);
}
struct EpiBranch { unsigned char* ws;
    DEVINL bool keep(const GUnit& u) const { return u.sub != 2; }
    DEVINL void operator()(GAcc& acc, const GUnit& u, int wr, int wc, int fr, int fq) const {
        const int i = u.sub;
        const unsigned char* Gc = ws + (i == 0 ? WS_G0 : (i == 1 ? WS_G1 : WS_G2));
        const unsigned char* Gn = ws + (i == 0 ? WS_G1 : WS_G2);
        u16* M = (u16*)(ws + WS_MERGED);
#pragma unroll
        for (int ai = 0; ai < 2; ++ai)
#pragma unroll
            for (int m = 0; m < 4; ++m) {
                const size_t off = (size_t)G_ROW(u, ai, m) * 1024 + u.pn * 256 + wc * 64 + fq * 16;
                const u32x4 g = *(const u32x4*)(Gc + off);
                u32x4 h = g;
                if (i != 2) h = *(const u32x4*)(Gn + off);
#pragma unroll
                for (int bj = 0; bj < 2; ++bj)
#pragma unroll
                    for (int n = 0; n < 2; ++n) {
                        const unsigned gw = g[bj * 2 + n], hw = h[bj * 2 + n];
                        f32x4 v = acc[ai][bj][m][n];
#pragma unroll
                        for (int j = 0; j < 4; ++j) {
                            const float gq = (float)((gw >> (8 * j)) & 255u);
                            v[j] *= (i != 2) ? gq * __builtin_amdgcn_rcpf((float)((hw >> (8 * j)) & 255u)) : gq * (1.f / 255.f);
                        }
                        acc[ai][bj][m][n] = v;
                    }
                if (i == 2) { st8bf(M + off, acc[ai][0][m][0], acc[ai][0][m][1]); st8bf(M + off + 8, acc[ai][1][m][0], acc[ai][1][m][1]); }
            }
    }
};
DEVINL void ph_branch(const Params& p, LAS unsigned char* lds) {
    unsigned char* ws = WSP(p);
    BranchSched S{(const char*)(ws + WS_RG), (const char*)(ws + WS_FQ), (const char*)(ws + WS_YC), (const char*)(ws + WS_BR)};
    gemm_phase(lds, S, EpiBranch{ws}, 512, 512, 512);
}
template <bool XBF>
struct EpiOut { const void* xin; u16* out; const float* gt;
    DEVINL bool keep(const GUnit&) const { return false; }
    DEVINL void operator()(const GAcc& acc, const GUnit& u, int wr, int wc, int fr, int fq) const {
        const int b = u.pm >> 4, c = u.pn * 256 + wc * 64 + fq * 16;
        float g[16];
#pragma unroll
        for (int q = 0; q < 4; ++q) { const float4 g4 = *(const float4*)(gt + b * 6144 + c + q * 4); g[q * 4] = g4.x; g[q * 4 + 1] = g4.y; g[q * 4 + 2] = g4.z; g[q * 4 + 3] = g4.w; }
#pragma unroll
        for (int ai = 0; ai < 2; ++ai)
#pragma unroll
            for (int m = 0; m < 4; ++m) {
                const size_t off = (size_t)G_ROW(u, ai, m) * 1024 + c;
                float xa[16];
                if constexpr (XBF) {
#pragma unroll
                    for (int q = 0; q < 2; ++q) { const u32x4 v = *(const u32x4*)((const u16*)xin + off + q * 8);
                        xa[q * 8 + 0] = lo2f(v[0]); xa[q * 8 + 1] = hi2f(v[0]); xa[q * 8 + 2] = lo2f(v[1]); xa[q * 8 + 3] = hi2f(v[1]); xa[q * 8 + 4] = lo2f(v[2]); xa[q * 8 + 5] = hi2f(v[2]); xa[q * 8 + 6] = lo2f(v[3]); xa[q * 8 + 7] = hi2f(v[3]); }
                } else {
#pragma unroll
                    for (int q = 0; q < 4; ++q) { const float4 v = *(const float4*)((const float*)xin + off + q * 4); xa[q * 4] = v.x; xa[q * 4 + 1] = v.y; xa[q * 4 + 2] = v.z; xa[q * 4 + 3] = v.w; }
                }
#pragma unroll
                for (int bj = 0; bj < 2; ++bj) {
                    const f32x4 a0 = acc[ai][bj][m][0], a1 = acc[ai][bj][m][1];
                    const float* xb = xa + bj * 8; const float* gb = g + bj * 8;
                    const u32x4 o = {pk2(xb[0] + gb[0] * a0[0], xb[1] + gb[1] * a0[1]), pk2(xb[2] + gb[2] * a0[2], xb[3] + gb[3] * a0[3]),
                                     pk2(xb[4] + gb[4] * a1[0], xb[5] + gb[5] * a1[1]), pk2(xb[6] + gb[6] * a1[2], xb[7] + gb[7] * a1[3])};
                    *(u32x4*)(out + off + bj * 8) = o;
                }
            }
    }
};
DEVINL void ph_gemm_out(const Params& p, int l, LAS unsigned char* lds) {
    unsigned char* ws = WSP(p);
    DenseSched S{(const char*)(ws + WS_MERGED), (const char*)(ws + WS_OUTW), 1024, 1024, 256, 4, 0ull};
    const float* gt = (const float*)(ws + WS_MOD) + (size_t)l * 16 * 6144 + 2 * 1024;
    if (l == 0) gemm_phase(lds, S, EpiOut<false>{(const void*)p.in[I_X], (u16*)(ws + WS_XM), gt}, 1024, 1024, 1024);
    else gemm_phase(lds, S, EpiOut<true>{(const void*)p.out, (u16*)(ws + WS_XM), gt}, 1024, 1024, 1024);
}

DEVINL void moe_offsets(const Params& p, int l, LAS int* poff  ) {
    if (TID() == 0) {
        const unsigned* cnt = (const unsigned*)(WSP(p) + WS_CTL) + CW_CNT + l * 32;
        int a = 0;
        for (int e = 0; e < 32; ++e) { poff[e] = a; a += (int)((cnt[e] + 255u) & ~255u); }
        poff[32] = a;
    }
    __syncthreads();
}
DEVINL void ph_scatter(const Params& p, int l, LAS unsigned char* lds) {
    unsigned char* ws = WSP(p);
    LAS int* poff = (LAS int*)lds;
    moe_offsets(p, l, poff);
    int* tokl = (int*)(ws + WS_TOKL); float* wl = (float*)(ws + WS_WL);
    const int4* rt = (const int4*)(ws + WS_ROUTE);
    for (int i = blockIdx.x * NTHR + TID(); i < T_ * 2; i += gridDim.x * NTHR) {
        const int4 r = rt[i];
        const int d = poff[r.x] + r.y;
        tokl[d] = i >> 1; wl[d] = __int_as_float(r.z);
    }
    const unsigned* cnt = (const unsigned*)(ws + WS_CTL) + CW_CNT + l * 32;
    for (int i = blockIdx.x * NTHR + TID(); i < 32 * 256; i += gridDim.x * NTHR) {
        const int e = i >> 8, r = poff[e] + (int)cnt[e] + (i & 255);
        if (r < poff[e + 1]) { tokl[r] = 0; wl[r] = 0.f; }
    }
    __syncthreads();
}
struct EpiUp { unsigned char* hid;
    DEVINL bool keep(const GUnit&) const { return false; }
    DEVINL void operator()(const GAcc& acc, const GUnit& u, int wr, int wc, int fr, int fq) const {
        constexpr float R = 1.f / W8_SCALE;
#pragma unroll
        for (int ai = 0; ai < 2; ++ai)
#pragma unroll
            for (int m = 0; m < 4; ++m) {
                float v[8];
#pragma unroll
                for (int bj = 0; bj < 2; ++bj) {
                    const f32x4 a = acc[ai][bj][m][0], c = acc[ai][bj][m][1];
#pragma unroll
                    for (int j = 0; j < 4; ++j) v[bj * 4 + j] = siluf_(a[j] * R) * (c[j] * R);
                }
                u32x2 o = {pk4_f8(v[0], v[1], v[2], v[3]), pk4_f8(v[4], v[5], v[6], v[7])};
                *(u32x2*)(hid + (size_t)G_ROW(u, ai, m) * 512 + u.pn * 128 + wc * 32 + fq * 8) = o;
            }
    }
};
DEVINL void ph_moe_up(const Params& p, int l, LAS unsigned char* lds) {
    unsigned char* ws = WSP(p);
    LAS int* poff = (LAS int*)(lds + LDS_POFF);
    moe_offsets(p, l, poff);
    MoeGatherSched S{(const char*)(ws + WS_H), (const char*)(ws + WS_W13), 512, (size_t)1024 * 1024, poff, (const int*)(ws + WS_TOKL)};
    gemm_phase_t<false, true, G_SP2, G_ALIGN, true>(lds, S, EpiUp{ws + WS_HID}, 512, 512, 512);
}
struct EpiDown { u16* y; const float* wl;
    DEVINL bool keep(const GUnit&) const { return false; }
    DEVINL void operator()(const GAcc& acc, const GUnit& u, int wr, int wc, int fr, int fq) const {
#pragma unroll
        for (int ai = 0; ai < 2; ++ai)
#pragma unroll
            for (int m = 0; m < 4; ++m) {
                const int row = G_ROW(u, ai, m);
                const float w = wl[row] * (1.f / W8_SCALE);
                u16* rp = y + (size_t)row * 1024 + u.pn * 256 + wc * 64 + fq * 16;
#pragma unroll
                for (int bj = 0; bj < 2; ++bj) {
                    f32x4 v0 = acc[ai][bj][m][0], v1 = acc[ai][bj][m][1];
                    v0[0] *= w; v0[1] *= w; v0[2] *= w; v0[3] *= w; v1[0] *= w; v1[1] *= w; v1[2] *= w; v1[3] *= w;
                    st8bf(rp + bj * 8, v0, v1);
                }
            }
    }
};
DEVINL void ph_moe_down(const Params& p, int l, LAS unsigned char* lds) {
    unsigned char* ws = WSP(p);
    LAS int* poff = (LAS int*)(lds + LDS_POFF);
    moe_offsets(p, l, poff);
    MoeSched S{(const char*)(ws + WS_HID), (const char*)(ws + WS_W2), 256, 256, (size_t)1024 * 512, poff};
    gemm_phase_t<false, false, G_SP2, G_ALIGN, true>(lds, S, EpiDown{(u16*)(ws + WS_YEXP), (const float*)(ws + WS_WL)}, 256, 256, 256);
}

template <bool LAST>
DEVINL void ph_combine(const Params& p, int l, LAS unsigned char* lds) {
    unsigned char* ws = WSP(p);
    LAS int* poff = (LAS int*)lds;
    moe_offsets(p, l, poff);
    const int lane = TID() & 63, gw = blockIdx.x * 8 + (TID() >> 6), GW = gridDim.x * 8;
    const float* mod = (const float*)(ws + WS_MOD) + (size_t)l * 16 * 6144;
    const float* modn = (const float*)(ws + WS_MOD) + (size_t)(l + 1) * 16 * 6144;
    const int4* rt = (const int4*)(ws + WS_ROUTE);
    const u16* Y = (const u16*)(ws + WS_YEXP);
    u16* H = (u16*)(ws + WS_H);
    const u16* XM = (const u16*)(ws + WS_XM);
    unsigned char* H8 = H8P(p);
    u16* X1 = (u16*)p.out;
    for (int t0 = gw * 32; t0 < T_; t0 += GW * 32) {
        const int b = t0 >> 12;
        float gt[16], gs[16], sv[16];
#pragma unroll
        for (int i = 0; i < 4; ++i) { const float4 g4 = *(const float4*)(mod + b * 6144 + 5 * 1024 + i * 256 + lane * 4); gt[i * 4] = g4.x; gt[i * 4 + 1] = g4.y; gt[i * 4 + 2] = g4.z; gt[i * 4 + 3] = g4.w; }
        if (!LAST) norm_consts(p.in[I_N1G] + (size_t)(l + 1) * 1024, modn, modn + 1024, b, lane, gs, sv);
        else {
#pragma unroll
            for (int i = 0; i < 4; ++i) { const float4 g4 = *(const float4*)(p.in[I_FING] + i * 256 + lane * 4); gs[i * 4] = g4.x; gs[i * 4 + 1] = g4.y; gs[i * 4 + 2] = g4.z; gs[i * 4 + 3] = g4.w; }
        }
#pragma unroll 1
        for (int r = 0; r < 32; r += 2) {
            float xv[2][16];
#pragma unroll
            for (int q = 0; q < 2; ++q) {
                const int t = t0 + r + q;
                const int4 r0 = rt[t * 2], r1 = rt[t * 2 + 1];
                const u16* y0 = Y + (size_t)(poff[r0.x] + r0.y) * 1024; const u16* y1 = Y + (size_t)(poff[r1.x] + r1.y) * 1024;
#pragma unroll
                for (int i = 0; i < 4; ++i) {
                    const int c0 = i * 256 + lane * 4;
                    const u32x2 v = *(const u32x2*)(XM + (size_t)t * 1024 + c0);
                    const u32x2 a = *(const u32x2*)(y0 + c0), c = *(const u32x2*)(y1 + c0);
                    xv[q][i * 4 + 0] = lo2f(v[0]) + gt[i * 4 + 0] * (lo2f(a[0]) + lo2f(c[0]));
                    xv[q][i * 4 + 1] = hi2f(v[0]) + gt[i * 4 + 1] * (hi2f(a[0]) + hi2f(c[0]));
                    xv[q][i * 4 + 2] = lo2f(v[1]) + gt[i * 4 + 2] * (lo2f(a[1]) + lo2f(c[1]));
                    xv[q][i * 4 + 3] = hi2f(v[1]) + gt[i * 4 + 3] * (hi2f(a[1]) + hi2f(c[1]));
                }
            }
#pragma unroll
            for (int q = 0; q < 2; ++q) {
                const int t = t0 + r + q;
                if (!LAST) {
#pragma unroll
                    for (int i = 0; i < 4; ++i) { const u32x2 o = {pk2(xv[q][i * 4], xv[q][i * 4 + 1]), pk2(xv[q][i * 4 + 2], xv[q][i * 4 + 3])}; *(u32x2*)(X1 + (size_t)t * 1024 + i * 256 + lane * 4) = o; }
                    norm_store_row(H + (size_t)t * 1024, H8 + (size_t)t * 1024, lane, xv[q], gs, sv);
                } else {
                    float ss = 0.f;
#pragma unroll
                    for (int i = 0; i < 16; ++i) ss += xv[q][i] * xv[q][i];
                    ss = wsum(ss);
                    const float rstd = rsqrtf(ss * (1.f / 1024.f) + EPS);
#pragma unroll
                    for (int i = 0; i < 4; ++i)
                        *(float4*)(p.out + (size_t)t * 1024 + i * 256 + lane * 4) = make_float4(xv[q][i * 4] * rstd * gs[i * 4], xv[q][i * 4 + 1] * rstd * gs[i * 4 + 1], xv[q][i * 4 + 2] * rstd * gs[i * 4 + 2], xv[q][i * 4 + 3] * rstd * gs[i * 4 + 3]);
                }
            }
        }
    }
}

constexpr int NPL = 12, NPHASES = 2 + 2 * NPL;

__global__ void __launch_bounds__(NTHR, 2) mega(Params p) {
    extern __shared__ __attribute__((aligned(16))) unsigned char lds_raw[];
    LAS unsigned char* lds = (LAS unsigned char*)lds_raw;
    LAS unsigned* xbw = (LAS unsigned*)(lds + LDS_BYTES - 16);
    if (threadIdx.x == 0) { xbw[0] = 0u; xbw[1] = 0u; xbw[2] = 0u; xbw[3] = 0u; }
    __syncthreads();
    XcdBarrier bar; bar.bar = (unsigned*)(p.ws + WS_CTL); bar.x = 0; bar.st = (volatile LAS unsigned*)xbw;
    const bool multi = (p.ph_hi - p.ph_lo) > 1;
    if (multi) bar = xcd_barrier_post((unsigned*)(p.ws + WS_CTL), (volatile LAS unsigned*)xbw);
    const int lo = p.ph_lo, hi = p.ph_hi;
#ifdef ONLY
#define PHEN(k) (((k) < 2 ? (k) : 2 + ((k) - 2) % NPL) == ONLY)
#elif defined(SKIP)
#define PHEN(k) (((k) < 2 ? (k) : 2 + ((k) - 2) % NPL) != SKIP)
#else
#define PHEN(k) true
#endif
#define IN(k) (PHEN(k) && lo <= (k) && (k) < hi)
#define SEAM(k) do { if (IN(k) && IN((k) + 1)) xcd_barrier(bar); } while (0)
    unsigned char* ws = p.ws;

    if (IN(0)) { ph_mod(p, lds); ph_rope_table(p); ph_conv_layer(p, 0, lds); }
    SEAM(0);
    if (IN(1)) { ph_rtab(p); ph_norm(p, 0, p.in[I_X], p.in[I_N1G], 0, 1024); }
    SEAM(1);
#pragma unroll
    for (int l = 0; l < 2; ++l) {
        const int pb = 2 + l * NPL;
        if (IN(pb + 0)) ph_gemm_in(p, lds);
        SEAM(pb + 0);
        if (IN(pb + 1)) {
            rmsnorm_inplace<256>((u16*)(ws + WS_MQ), p.in[I_MQG] + l * 256);
            rmsnorm_inplace<128>((u16*)(ws + WS_MKV), p.in[I_MKVG] + l * 128);
            ph_fcum(p, l, lds);
            ph_kmax(p, l);
        }
        SEAM(pb + 1);
        if (IN(pb + 2)) ph_gemm_mla_up(p, lds);
        SEAM(pb + 2);
        if (IN(pb + 3)) ph_mixers(p, l, lds);
        SEAM(pb + 3);
        if (IN(pb + 4)) ph_gates(p, l, lds);
        SEAM(pb + 4);
        if (IN(pb + 5)) ph_branch(p, lds);
        SEAM(pb + 5);
        if (IN(pb + 6)) ph_gemm_out(p, l, lds);
        SEAM(pb + 6);
        if (IN(pb + 7)) ph_norm_route(p, l, lds);
        SEAM(pb + 7);
        if (IN(pb + 8)) ph_scatter(p, l, lds);
        SEAM(pb + 8);
        if (IN(pb + 9)) ph_moe_up(p, l, lds);
        SEAM(pb + 9);
        if (IN(pb + 10)) ph_moe_down(p, l, lds);
        SEAM(pb + 10);
        if (IN(pb + 11)) {
            if (l == 0) { ph_conv_layer(p, 1, lds); ph_combine<false>(p, 0, lds); }
            else ph_combine<true>(p, 1, lds);
        }
        if (l == 0) SEAM(pb + 11);
    }
#undef IN
#undef SEAM
}

extern "C" void kernel_launch(void* const* d_in, const int* in_sizes, int n_in, void* d_out, int out_size, void* d_ws, size_t ws_size, hipStream_t stream) {
    static int grid = 0;
    if (grid == 0) {
        if (n_in != 25 || out_size != T_ * DM || ws_size < WS_END2) { fprintf(stderr, "kernel_launch: unexpected shapes (n_in %d out %d ws %zu)\n", n_in, out_size, ws_size); grid = -1; return; }
        int dev = 0, cus = 0;
        if (hipGetDevice(&dev) != hipSuccess || hipDeviceGetAttribute(&cus, hipDeviceAttributeMultiprocessorCount, dev) != hipSuccess) { grid = -1; return; }
        if (hipFuncSetAttribute((const void*)mega, hipFuncAttributeMaxDynamicSharedMemorySize, LDS_BYTES) != hipSuccess) { fprintf(stderr, "hipFuncSetAttribute failed\n"); grid = -1; return; }
        int per_cu = 0;
        if (hipOccupancyMaxActiveBlocksPerMultiprocessor(&per_cu, (const void*)mega, NTHR, LDS_BYTES) != hipSuccess || per_cu < 1) { fprintf(stderr, "occupancy query: %d\n", per_cu); }
        (void)hipGetLastError();
        grid = cus;
    }
    if (grid < 0) return;
    (void)in_sizes;
    hipMemsetAsync((char*)d_ws + WS_CTL, 0, CTL_ZERO_BYTES, stream);
    Params p{};
    for (int i = 0; i < 25; ++i) p.in[i] = (const float*)d_in[i];
    p.out = (float*)d_out; p.ws = (unsigned char*)d_ws;
#ifndef N_LAUNCH_SPLIT
#define N_LAUNCH_SPLIT 0
#endif
#if N_LAUNCH_SPLIT
    for (int ph = 0; ph < NPHASES; ++ph) { p.ph_lo = ph; p.ph_hi = ph + 1; hipLaunchKernelGGL(mega, dim3(grid), dim3(NTHR), LDS_BYTES, stream, p); }
#else
    p.ph_lo = 0; p.ph_hi = NPHASES; hipLaunchKernelGGL(mega, dim3(grid), dim3(NTHR), LDS_BYTES, stream, p);
#endif
}
```

```cpp
#include <hip/hip_runtime.h>
#include <stdint.h>
#include <stdio.h>

typedef unsigned short u16;
typedef short bf16x8 __attribute__((ext_vector_type(8)));
typedef float f32x4 __attribute__((ext_vector_type(4)));
typedef unsigned u32x2 __attribute__((ext_vector_type(2)));
typedef unsigned u32x4 __attribute__((ext_vector_type(4)));
#define LAS __attribute__((address_space(3)))
#define DEVINL __device__ __forceinline__

constexpr int T_ = 65536, DM = 1024, NBATCH = 16, SEQ = 4096, NTHR = 512;
constexpr int PROWS = 131072 + 32 * 256;
constexpr float EPS = 1e-6f;

enum { I_X = 0, I_C, I_POS, I_ADAW, I_ADAB, I_N1G, I_N2G, I_WIN, I_FOXFB, I_MQG, I_WQUP, I_MKVG, I_WKVUP, I_GATEW, I_GATEB,
       I_BRW, I_OUTW, I_RGW, I_RGB, I_REW, I_REB, I_W1, I_W3, I_W2, I_FING };

constexpr size_t MB = 1ull << 20;
constexpr size_t WS_CTL = 0, WS_MOD = 1 * MB, WS_FCUM = 2 * MB, WS_FFL = 3 * MB, WS_ROUTE = 4 * MB, WS_TOKL = 6 * MB, WS_WL = 7 * MB,
                 WS_ROPE = 8 * MB, WS_WIN = 24 * MB, WS_GATE = 31 * MB, WS_BR = 37 * MB, WS_OUTW = 40 * MB, WS_WQ = 42 * MB,
                 WS_WKV = 43 * MB, WS_W13 = 44 * MB, WS_W2 = 108 * MB, WS_H = 140 * MB, WS_RQK = 268 * MB, WS_RV = 332 * MB,
                 WS_RG = 396 * MB, WS_FQ = 460 * MB, WS_FK = 524 * MB, WS_FV = 588 * MB, WS_MQ = 652 * MB, WS_MKV = 684 * MB,
                 WS_KPE = 700 * MB, WS_Q = 708 * MB, WS_KV = 804 * MB, WS_END = 932 * MB,
                 WS_HID = 268 * MB, WS_YEXP = 404 * MB, WS_MERGED = WS_H,
                 WS_FVT = WS_FV, WS_RVT = WS_RV, WS_KN = WS_KV, WS_MVT = WS_KV + 64 * MB, WS_XM = WS_KV,

                 WS_YC = 932 * MB, WS_G0 = WS_RQK, WS_G1 = WS_FK, WS_G2 = WS_KV, WS_RTAB = 996 * MB, WS_RCJ = 1003 * MB, WS_END2 = 1004 * MB,
                 WS_H8A = WS_W13 + 32 * MB, WS_H8B = WS_MQ;
constexpr size_t CTL_ZERO_BYTES = 64 * 1024;
constexpr int CW_CNT = 4096;
constexpr int CW_KMAX = 4224;

constexpr int LDS_BYTES = 146 * 1024;

struct Params { const float* in[25]; float* out; unsigned char* ws; int ph_lo, ph_hi; };

DEVINL float bf2f(u16 v) { return __uint_as_float(((unsigned)v) << 16); }
DEVINL u16 f2bf(float f) { unsigned u = __float_as_uint(f); u += 0x7FFFu + ((u >> 16) & 1u); return (u16)(u >> 16); }
typedef float f32x2 __attribute__((ext_vector_type(2)));
typedef __bf16 bf16x2_t __attribute__((ext_vector_type(2)));
DEVINL unsigned pk2(float lo, float hi) { f32x2 v = {lo, hi}; bf16x2_t b = __builtin_convertvector(v, bf16x2_t); return *reinterpret_cast<unsigned*>(&b); }
typedef int v8i __attribute__((ext_vector_type(8)));
typedef int v4i __attribute__((ext_vector_type(4)));
DEVINL unsigned pk4_f8(float a, float b, float c, float d) { int w = __builtin_amdgcn_cvt_pk_fp8_f32(a, b, 0, false); w = __builtin_amdgcn_cvt_pk_fp8_f32(c, d, w, true); return (unsigned)w; }
DEVINL float lo2f(unsigned v) { return __uint_as_float(v << 16); }
DEVINL float hi2f(unsigned v) { return __uint_as_float(v & 0xFFFF0000u); }
DEVINL float wsum(float v) { for (int o = 32; o; o >>= 1) v += __shfl_xor(v, o); return v; }
DEVINL float sigmoidf_(float x) { return __builtin_amdgcn_rcpf(1.f + __builtin_amdgcn_exp2f(x * -1.4426950408889634f)); }
DEVINL float siluf_(float x) { return x * __builtin_amdgcn_rcpf(1.f + __builtin_amdgcn_exp2f(x * -1.4426950408889634f)); }

__device__ const float ROPE_INV[32] = {
    1.000000000e+00f, 7.498942614e-01f, 5.623413324e-01f, 4.216965139e-01f, 3.162277639e-01f, 2.371373773e-01f, 1.778279394e-01f, 1.333521307e-01f,
    1.000000015e-01f, 7.498941571e-02f, 5.623413250e-02f, 4.216965288e-02f, 3.162277490e-02f, 2.371373773e-02f, 1.778279431e-02f, 1.333521493e-02f,
    9.999999776e-03f, 7.498941850e-03f, 5.623413250e-03f, 4.216964822e-03f, 3.162277630e-03f, 2.371373586e-03f, 1.778279431e-03f, 1.333521446e-03f,
    1.000000047e-03f, 7.498942432e-04f, 5.623413017e-04f, 4.216965172e-04f, 3.162277571e-04f, 2.371373703e-04f, 1.778279402e-04f, 1.333521504e-04f};

#define XB_TMO      128
#define XB_XCNT(j)  (256  + 64 * (j))
#define XB_XSUB(j)  (1280 + 64 * (j))
#define XB_XGEN(j)  (2304 + 64 * (j))
#define XB_TOP      3328
#define XB_TOPGEN   3392
#define XCD_BAR_WORDS 3456
#define XB_SPIN_CAP (1u << 20)

__device__ __forceinline__ unsigned xb_ld(unsigned* p)              { return __hip_atomic_load(p, __ATOMIC_RELAXED, __HIP_MEMORY_SCOPE_AGENT); }
__device__ __forceinline__ unsigned xb_add(unsigned* p, unsigned v) { return __hip_atomic_fetch_add(p, v, __ATOMIC_RELAXED, __HIP_MEMORY_SCOPE_AGENT); }
__device__ __forceinline__ unsigned xb_xcc_id() { return (unsigned)__builtin_amdgcn_s_getreg((3 << 11) | 20) & 0xFu; }
#define XB_SPIN(cond, bar) do { unsigned _sp = 0; while (cond) { __builtin_amdgcn_s_sleep(1); \
    if ((++_sp & 255u) == 0u) { if (xb_ld(&(bar)[XB_TMO])) break; if (_sp > XB_SPIN_CAP) { atomicAdd(&(bar)[XB_TMO], 1u); break; } } } } while (0)

struct XcdBarrier { unsigned* bar; unsigned x; volatile LAS unsigned* st; };

__device__ __forceinline__ XcdBarrier xcd_barrier_post(unsigned* bar, volatile LAS unsigned* st) {
    XcdBarrier b; b.bar = bar; b.x = xb_xcc_id(); b.st = st;
    if (threadIdx.x == 0) (void)xb_add(&bar[XB_XCNT(b.x)], 1u);
    return b;
}
__device__ __forceinline__ void xcd_barrier_complete(unsigned* bar, unsigned x, unsigned& nloc, unsigned& nx) {
    const unsigned G = gridDim.x * gridDim.y * gridDim.z;
    unsigned sum, cnt, mine, sp = 0u;
    for (;;) {
        sum = 0u; cnt = 0u; mine = 0u;
#pragma unroll
        for (unsigned j = 0; j < 16; ++j) { const unsigned c = xb_ld(&bar[XB_XCNT(j)]); sum += c; cnt += (c > 0u) ? 1u : 0u; mine = (j == x) ? c : mine; }
        if (sum == G) break;
        __builtin_amdgcn_s_sleep(1);
        if ((++sp & 255u) == 0u) { if (xb_ld(&bar[XB_TMO])) break; if (sp > XB_SPIN_CAP) { atomicAdd(&bar[XB_TMO], 1u); break; } }
    }
    nloc = mine > 0u ? mine : 1u; nx = cnt > 0u ? cnt : 1u;
}
__device__ __forceinline__ void xcd_barrier(const XcdBarrier& b) {
    asm volatile("s_waitcnt vmcnt(0)" ::: "memory");
    __syncthreads();
    if (threadIdx.x == 0) {
        unsigned* bar = b.bar;
        __builtin_amdgcn_s_waitcnt(0);
        unsigned nloc = b.st[0], nx = b.st[1];
        if (nloc == 0u) { xcd_barrier_complete(bar, b.x, nloc, nx); b.st[0] = nloc; b.st[1] = nx; }
        const unsigned old = xb_add(&bar[XB_XSUB(b.x)], 1u);
        const unsigned gen = old / nloc;
        if (old + 1u == (gen + 1u) * nloc) {
            __builtin_amdgcn_fence(__ATOMIC_RELEASE, "agent");
            asm volatile("s_waitcnt vmcnt(0)" ::: "memory");
            const unsigned og = xb_add(&bar[XB_TOP], 1u);
            const unsigned tg = og / nx;
            if (og + 1u == (tg + 1u) * nx) xb_add(&bar[XB_TOPGEN], 1u);
            else XB_SPIN(xb_ld(&bar[XB_TOPGEN]) == tg, bar);
            __builtin_amdgcn_fence(__ATOMIC_ACQUIRE, "agent");
            xb_add(&bar[XB_XGEN(b.x)], 1u);
            asm volatile("s_waitcnt vmcnt(0)" ::: "memory");
        } else {
            XB_SPIN(xb_ld(&bar[XB_XGEN(b.x)]) == gen, bar);
            __builtin_amdgcn_fence(__ATOMIC_ACQUIRE, "agent");
            asm volatile("s_waitcnt vmcnt(0)" ::: "memory");
        }
    }
    __syncthreads();
}

DEVINL int BID() { int b = blockIdx.x; asm volatile("" : "+s"(b)); return b; }
DEVINL int TID() { int t = threadIdx.x; asm volatile("" : "+v"(t)); return t; }
DEVINL unsigned char* WSP(const Params& p) { unsigned char* w = p.ws; asm volatile("" : "+s"(w)); return w; }

DEVINL void ph_mod(const Params& p, LAS unsigned char* lds) {
    LAS float* cact = (LAS float*)lds;
    LAS float* red = (LAS float*)(lds + 65536);
    const int tid = TID(), lane = tid & 63, wave = tid >> 6;
    if ((int)blockIdx.x >= 48) return;
    const float* c = p.in[I_C];
#pragma unroll 8
    for (int i = tid; i < 16 * 1024; i += NTHR) cact[i] = siluf_(c[i]);
    __syncthreads();
    float* mod = (float*)(WSP(p) + WS_MOD);
    for (int u = blockIdx.x; u < 48; u += gridDim.x) {
        const int l = u / 24, cb = u % 24;
        const float* w = p.in[I_ADAW] + (size_t)l * 1024 * 6144 + cb * 256 + lane * 4;
        float acc[16][4];
#pragma unroll
        for (int bb = 0; bb < 16; ++bb) { acc[bb][0] = 0.f; acc[bb][1] = 0.f; acc[bb][2] = 0.f; acc[bb][3] = 0.f; }
#pragma unroll 1
        for (int k0 = wave * 128; k0 < wave * 128 + 128; k0 += 4) {
            float4 wv[4];
#pragma unroll
            for (int j = 0; j < 4; ++j) wv[j] = *(const float4*)(w + (size_t)(k0 + j) * 6144);
#pragma unroll
            for (int j = 0; j < 4; ++j)
#pragma unroll
                for (int bb = 0; bb < 16; ++bb) { const float cv = cact[bb * 1024 + k0 + j]; acc[bb][0] += cv * wv[j].x; acc[bb][1] += cv * wv[j].y; acc[bb][2] += cv * wv[j].z; acc[bb][3] += cv * wv[j].w; }
        }
#pragma unroll
        for (int rnd = 0; rnd < 2; ++rnd) {
#pragma unroll
            for (int bb = 0; bb < 8; ++bb) *(LAS f32x4*)(red + ((wave * 8 + bb) * 256 + lane * 4)) = f32x4{acc[rnd * 8 + bb][0], acc[rnd * 8 + bb][1], acc[rnd * 8 + bb][2], acc[rnd * 8 + bb][3]};
            __syncthreads();
            for (int o = tid; o < 8 * 256; o += NTHR) {
                const int bb = o >> 8, jj = o & 255;
                float sum = 0.f;
#pragma unroll
                for (int q = 0; q < 8; ++q) sum += red[(q * 8 + bb) * 256 + jj];
                const int jg = cb * 256 + jj;
                mod[((size_t)l * 16 + rnd * 8 + bb) * 6144 + jg] = sum + p.in[I_ADAB][l * 6144 + jg];
            }
            __syncthreads();
        }
    }
}

DEVINL void ph_rope_table(const Params& p) {
    const int* pos = (const int*)p.in[I_POS];
    float2* tab = (float2*)(WSP(p) + WS_ROPE);
    for (int idx = blockIdx.x * NTHR + TID(); idx < T_ * 32; idx += gridDim.x * NTHR) {
        const int t = idx >> 5, i = idx & 31;
        const float ang = (float)pos[t] * ROPE_INV[i];
        const double a = (double)ang;
        const double k = rint(a * 0.15915494309189535);
        const double r = a - k * 6.283185307179586;
        const double q = rint(r * 0.6366197723675814);
        const double y = r - q * 1.5707963267948966;
        const double y2 = y * y;
        const double sn = y * (1.0 + y2 * (-1.0 / 6 + y2 * (1.0 / 120 + y2 * (-1.0 / 5040 + y2 * (1.0 / 362880 + y2 * (-1.0 / 39916800))))));
        const double cs = 1.0 + y2 * (-0.5 + y2 * (1.0 / 24 + y2 * (-1.0 / 720 + y2 * (1.0 / 40320 + y2 * (-1.0 / 3628800 + y2 * (1.0 / 479001600))))));
        const int qi = ((int)q) & 3;
        double co, si;
        if (qi == 0) { co = cs; si = sn; } else if (qi == 1) { co = -sn; si = cs; } else if (qi == 2) { co = -cs; si = -sn; } else { co = sn; si = -cs; }
        tab[idx] = make_float2((float)co, (float)si);
    }
}

DEVINL int p8(int n) { return (n & ~31) + ((n >> 2) & 1) * 16 + ((n >> 3) & 3) * 4 + (n & 3); }
DEVINL int rope_pos(int i) { return i < 32 ? ((i >> 4) * 32 + (i & 15)) : (((i - 32) >> 4) * 32 + 16 + ((i - 32) & 15)); }
template <int MAP> DEVINL int nmap(int n) {
    if (MAP == 1) {
        if (n < 512) return (n & ~63) + rope_pos(n & 63);
        if (n < 1024) return n;
        if (n < 2560) return p8(n);
        if (n < 3072) return n;
        if (n < 3076) return 3520 + (n - 3072);
        if (n < 3460) return p8(n - 4);
        return 3456 + rope_pos(n - 3460);
    }
    if (MAP == 4) { const int hh = n / 192, w = n - hh * 192; return w < 128 ? p8(n) : hh * 192 + 128 + rope_pos(w - 128); }
    if (MAP == 5) { const int hh = n >> 8, c = n & 255; return c < 128 ? p8(hh * 128 + c) : 512 + hh * 128 + (c - 128); }
    if (MAP == 2) return (n >> 7) * 256 + ((n >> 2) & 1) * 128 + ((n >> 5) & 3) * 32 + ((n >> 3) & 3) * 4 + (n & 3);
    if (MAP == 3) return (n >> 7) * 256 + ((n >> 2) & 1) * 128 + ((n >> 5) & 3) * 32 + 16 + ((n >> 3) & 3) * 4 + (n & 3);
    if (MAP == 6) return p8(n);
    if (MAP == 7) { const int c = n & 255; return (n & ~255) + ((c >> 3) & 1) * 128 + (c >> 6) * 32 + ((c >> 2) & 1) * 16 + ((c >> 4) & 3) * 4 + (c & 3); }
    return n;
}
constexpr float W8_SCALE = 64.f;
template <int MAP, bool F8>
DEVINL void conv_wx(const float* src, int nb, int K, int N, int Ntiles64, void* dst, size_t dst_bstride, LAS unsigned char* lds) {
    LAS float* tile = (LAS float*)lds;
    const int tid = TID(), c = tid & 63, r0 = tid >> 6;
    const int kt_n = K / 128, per_b = kt_n * Ntiles64, total = nb * per_b;
    float ld[16];
    int u = blockIdx.x;
#define CONV_LOAD(uu) do { const int b_ = (uu) / per_b, rem_ = (uu) % per_b, kt_ = rem_ / Ntiles64, nt_ = rem_ % Ntiles64; const float* s_ = src + (size_t)b_ * K * N; const int n_ = nt_ * 64 + c; \
        _Pragma("unroll") for (int i = 0; i < 16; ++i) { const int r = r0 + i * 8; ld[i] = (n_ < N) ? s_[(size_t)(kt_ * 128 + r) * N + n_] : 0.f; } } while (0)
    if (u < total) CONV_LOAD(u);
    for (; u < total; u += gridDim.x) {
        const int b = u / per_b, rem = u % per_b, kt = rem / Ntiles64, nt = rem % Ntiles64;
#pragma unroll
        for (int i = 0; i < 16; ++i) tile[(r0 + i * 8) * 65 + c] = F8 ? ld[i] * W8_SCALE : ld[i];
        __syncthreads();
        if (u + (int)gridDim.x < total) CONV_LOAD(u + (int)gridDim.x);
#pragma unroll
        for (int i = 0; i < 2; ++i) {
            const int item = tid + i * NTHR, rn = item >> 4, kg = item & 15, nn = nt * 64 + rn;
            const int drow = (nn < N) ? nmap<MAP>(nn) : nn;
            float v[8];
#pragma unroll
            for (int j = 0; j < 8; ++j) v[j] = tile[(kg * 8 + j) * 65 + rn];
            if constexpr (F8) {
                u32x2 o = {pk4_f8(v[0], v[1], v[2], v[3]), pk4_f8(v[4], v[5], v[6], v[7])};
                *(u32x2*)((unsigned char*)dst + (size_t)b * dst_bstride + (size_t)drow * K + kt * 128 + kg * 8) = o;
            } else {
                u32x4 o = {pk2(v[0], v[1]), pk2(v[2], v[3]), pk2(v[4], v[5]), pk2(v[6], v[7])};
                *(u32x4*)((u16*)dst + (size_t)b * dst_bstride + (size_t)drow * K + kt * 128 + kg * 8) = o;
            }
        }
        __syncthreads();
    }
#undef CONV_LOAD
}
template <int MAP> DEVINL void conv_w(const float* src, int nb, int K, int N, int Ntiles64, u16* dst, size_t dst_bstride, LAS unsigned char* lds) { conv_wx<MAP, false>(src, nb, K, N, Ntiles64, dst, dst_bstride, lds); }
template <int MAP> DEVINL void conv_w8(const float* src, int nb, int K, int N, int Ntiles64, unsigned char* dst, size_t dst_bstride, LAS unsigned char* lds) { conv_wx<MAP, true>(src, nb, K, N, Ntiles64, dst, dst_bstride, lds); }
DEVINL void ph_conv_layer(const Params& p, int l, LAS unsigned char* lds) {
    unsigned char* ws = WSP(p);
    conv_w<1>(p.in[I_WIN] + (size_t)l * 1024 * 3524, 1, 1024, 3524, 56, (u16*)(ws + WS_WIN), 0, lds);
    conv_w8<7>(p.in[I_GATEW] + (size_t)l * 1024 * 3072, 1, 1024, 3072, 48, ws + WS_GATE, 0, lds);
    conv_w<7>(p.in[I_BRW] + (size_t)l * 3 * 512 * 1024, 3, 512, 1024, 16, (u16*)(ws + WS_BR), (size_t)1024 * 512, lds);
    conv_w<7>(p.in[I_OUTW] + (size_t)l * 1024 * 1024, 1, 1024, 1024, 16, (u16*)(ws + WS_OUTW), 0, lds);
    conv_w<4>(p.in[I_WQUP] + (size_t)l * 256 * 768, 1, 256, 768, 12, (u16*)(ws + WS_WQ), 0, lds);
    conv_w<5>(p.in[I_WKVUP] + (size_t)l * 128 * 1024, 1, 128, 1024, 16, (u16*)(ws + WS_WKV), 0, lds);
    conv_w8<2>(p.in[I_W1] + (size_t)l * 32 * 1024 * 512, 32, 1024, 512, 8, ws + WS_W13, (size_t)1024 * 1024, lds);
    conv_w8<3>(p.in[I_W3] + (size_t)l * 32 * 1024 * 512, 32, 1024, 512, 8, ws + WS_W13, (size_t)1024 * 1024, lds);
    conv_w8<7>(p.in[I_W2] + (size_t)l * 32 * 512 * 1024, 32, 512, 1024, 16, ws + WS_W2, (size_t)1024 * 512, lds);
}

DEVINL unsigned char* H8P(const Params& p) { return (unsigned char*)p.out + (size_t)128 * MB; }
DEVINL void norm_consts(const float* g, const float* sh, const float* sc, int b, int lane, float (&gs)[16], float (&sv)[16]) {
#pragma unroll
    for (int i = 0; i < 4; ++i) {
        const int c0 = i * 256 + lane * 4;
        const float4 gv = *(const float4*)(g + c0), shv = *(const float4*)(sh + b * 6144 + c0), scv = *(const float4*)(sc + b * 6144 + c0);
        gs[i * 4 + 0] = gv.x * (1.f + scv.x); gs[i * 4 + 1] = gv.y * (1.f + scv.y); gs[i * 4 + 2] = gv.z * (1.f + scv.z); gs[i * 4 + 3] = gv.w * (1.f + scv.w);
        sv[i * 4 + 0] = shv.x; sv[i * 4 + 1] = shv.y; sv[i * 4 + 2] = shv.z; sv[i * 4 + 3] = shv.w;
    }
}
DEVINL void norm_store_row_f8(unsigned char* Hrow, int lane, const float (&xv)[16], const float (&gs)[16], const float (&sv)[16]) {
    float ss = 0.f;
#pragma unroll
    for (int i = 0; i < 16; ++i) ss += xv[i] * xv[i];
    ss = wsum(ss);
    const float rstd = rsqrtf(ss * (1.f / 1024.f) + EPS);
#pragma unroll
    for (int i = 0; i < 4; ++i)
        *(unsigned*)(Hrow + i * 256 + lane * 4) = pk4_f8(xv[i * 4 + 0] * rstd * gs[i * 4 + 0] + sv[i * 4 + 0], xv[i * 4 + 1] * rstd * gs[i * 4 + 1] + sv[i * 4 + 1],
                                                      xv[i * 4 + 2] * rstd * gs[i * 4 + 2] + sv[i * 4 + 2], xv[i * 4 + 3] * rstd * gs[i * 4 + 3] + sv[i * 4 + 3]);
}
DEVINL void norm_store_row(u16* Hrow, unsigned char* H8row, int lane, const float (&xv)[16], const float (&gs)[16], const float (&sv)[16]) {
    float ss = 0.f;
#pragma unroll
    for (int i = 0; i < 16; ++i) ss += xv[i] * xv[i];
    ss = wsum(ss);
    const float rstd = rsqrtf(ss * (1.f / 1024.f) + EPS);
#pragma unroll
    for (int i = 0; i < 4; ++i) {
        const float v0 = xv[i * 4 + 0] * rstd * gs[i * 4 + 0] + sv[i * 4 + 0], v1 = xv[i * 4 + 1] * rstd * gs[i * 4 + 1] + sv[i * 4 + 1];
        const float v2 = xv[i * 4 + 2] * rstd * gs[i * 4 + 2] + sv[i * 4 + 2], v3 = xv[i * 4 + 3] * rstd * gs[i * 4 + 3] + sv[i * 4 + 3];
        u32x2 o = {pk2(v0, v1), pk2(v2, v3)};
        *(u32x2*)(Hrow + i * 256 + lane * 4) = o;
        *(unsigned*)(H8row + i * 256 + lane * 4) = pk4_f8(lo2f(o[0]), hi2f(o[0]), lo2f(o[1]), hi2f(o[1]));
    }
}

DEVINL void ph_norm(const Params& p, int l, const float* xin, const float* g, int sh_off, int sc_off) {
    const int lane = TID() & 63, gw = blockIdx.x * 8 + (TID() >> 6), GW = gridDim.x * 8;
    const float* mod = (const float*)(WSP(p) + WS_MOD) + (size_t)l * 16 * 6144;
    u16* H = (u16*)(WSP(p) + WS_H);
    unsigned char* H8 = H8P(p);
    for (int t0 = gw * 32; t0 < T_; t0 += GW * 32) {
        float gs[16], sv[16];
        norm_consts(g, mod + sh_off, mod + sc_off, t0 >> 12, lane, gs, sv);
#pragma unroll 1
        for (int r = 0; r < 32; r += 2) {
            float xa[16], xb[16];
#pragma unroll
            for (int i = 0; i < 4; ++i) {
                const float4 v = *(const float4*)(xin + (size_t)(t0 + r) * 1024 + i * 256 + lane * 4), w = *(const float4*)(xin + (size_t)(t0 + r + 1) * 1024 + i * 256 + lane * 4);
                xa[i * 4] = v.x; xa[i * 4 + 1] = v.y; xa[i * 4 + 2] = v.z; xa[i * 4 + 3] = v.w; xb[i * 4] = w.x; xb[i * 4 + 1] = w.y; xb[i * 4 + 2] = w.z; xb[i * 4 + 3] = w.w;
            }
            norm_store_row(H + (size_t)(t0 + r) * 1024, H8 + (size_t)(t0 + r) * 1024, lane, xa, gs, sv);
            norm_store_row(H + (size_t)(t0 + r + 1) * 1024, H8 + (size_t)(t0 + r + 1) * 1024, lane, xb, gs, sv);
        }
    }
}

constexpr int RT_WH = 0, RT_WL = 49152, RT_CJ = 98304, RT_CNT = 98304 + 256;
DEVINL int rt_col(int r) { const int s_ = r >> 4, g_ = (r >> 2) & 3, j_ = r & 3; return s_ == 2 ? j_ : 4 + g_ * 8 + s_ * 4 + j_; }
DEVINL void ph_rtab(const Params& p) {
    unsigned char* ws = WSP(p);
    const int tid = TID(), lane = tid & 63, gw = blockIdx.x * 8 + (tid >> 6), GW = gridDim.x * 8;
    for (int idx = blockIdx.x * NTHR + tid; idx < 2 * 16 * 48 * 1024; idx += gridDim.x * NTHR) {
        const int lb = idx / (48 * 1024), rem = idx - lb * (48 * 1024), k = rem / 48, r = rem - k * 48, l = lb >> 4, b = lb & 15, col = rt_col(r);
        const float* mod = (const float*)(ws + WS_MOD) + (size_t)l * 16 * 6144 + b * 6144;
        const float wsrc = (col < 4) ? p.in[I_RGW][(size_t)l * 1024 * 4 + k * 4 + col] : p.in[I_REW][(size_t)l * 1024 * 32 + k * 32 + (col - 4)];
        const float w = p.in[I_N2G][l * 1024 + k] * (1.f + mod[4 * 1024 + k]) * wsrc;
        const u16 hi = (u16)(pk2(w, 0.f) & 0xFFFFu);
        const u16 lo = (u16)(pk2(w - bf2f(hi), 0.f) & 0xFFFFu);
        const int hf = k >> 9, kk = k & 511;
        unsigned char* img = ws + WS_RTAB + (size_t)(lb * 2 + hf) * 98304;
        const int off = r * 1024 + (((kk >> 3) ^ (r & 15)) * 16) + (kk & 7) * 2;
        *(u16*)(img + off) = hi; *(u16*)(img + 49152 + off) = lo;
    }
    for (int it = gw; it < 2 * 16 * 48; it += GW) {
        const int lb = it / 48, r = it - lb * 48, l = lb >> 4, b = lb & 15, col = rt_col(r);
        const float* sh = (const float*)(ws + WS_MOD) + (size_t)l * 16 * 6144 + b * 6144 + 3 * 1024;
        float a_ = 0.f;
        for (int k = lane; k < 1024; k += 64) a_ += sh[k] * ((col < 4) ? p.in[I_RGW][(size_t)l * 1024 * 4 + k * 4 + col] : p.in[I_REW][(size_t)l * 1024 * 32 + k * 32 + (col - 4)]);
        a_ = wsum(a_);
        if (lane == 0) ((float*)(ws + WS_RCJ))[it] = a_ + ((col < 4) ? p.in[I_RGB][l * 4 + col] : p.in[I_REB][l * 32 + (col - 4)]);
    }
}
DEVINL void ph_norm_route(const Params& p, int l, LAS unsigned char* lds) {
    unsigned char* ws = WSP(p);
    const int tid = TID(), lane = tid & 63, wave = __builtin_amdgcn_readfirstlane(tid >> 6), fr = lane & 15, fq = lane >> 4;
    const u16* x = (const u16*)(ws + WS_XM);
    const float* g2 = p.in[I_N2G] + (size_t)l * 1024;
    const float* mod = (const float*)(ws + WS_MOD) + (size_t)l * 16 * 6144;
    const float* wg = p.in[I_RGW] + (size_t)l * 1024 * 4;
    const float* we = p.in[I_REW] + (size_t)l * 1024 * 32;
    LAS float* cj = (LAS float*)(lds + RT_CJ);
    LAS unsigned* lcnt = (LAS unsigned*)(lds + RT_CNT);
    for (int blk = blockIdx.x; blk < 256; blk += gridDim.x) {
        const int b = blk >> 4;
        const float* sh = mod + b * 6144 + 3 * 1024; const float* sc = mod + b * 6144 + 4 * 1024;
        f32x4 acc[3][2];
#pragma unroll
        for (int s_ = 0; s_ < 3; ++s_) { acc[s_][0] = f32x4{0.f, 0.f, 0.f, 0.f}; acc[s_][1] = f32x4{0.f, 0.f, 0.f, 0.f}; }
        float ssq[2] = {0.f, 0.f};
        const u16* xr0 = x + (size_t)(blk * 256 + wave * 32 + fr) * 1024 + fq * 8;
#pragma unroll 1
        for (int hf = 0; hf < 2; ++hf) {
            {
                const u32x4* img = (const u32x4*)(ws + WS_RTAB + (size_t)((l * 16 + b) * 2 + hf) * 98304);
                u32x4 tv[12];
#pragma unroll
                for (int q = 0; q < 12; ++q) tv[q] = img[q * NTHR + tid];
#pragma unroll
                for (int q = 0; q < 12; ++q) *(LAS u32x4*)(lds + RT_WH + (q * NTHR + tid) * 16) = tv[q];
            }
            if (hf == 0) {
                if (tid < 32) lcnt[tid] = 0u;
                if (tid < 48) cj[tid] = ((const float*)(ws + WS_RCJ))[(l * 16 + b) * 48 + tid];
            }
            __syncthreads();
            const u16* xk = xr0 + hf * 512;
#pragma unroll 1
            for (int kg = 0; kg < 2; ++kg) {
                u32x4 xv[8][2];
#pragma unroll
                for (int q = 0; q < 8; ++q)
#pragma unroll
                    for (int ts = 0; ts < 2; ++ts) xv[q][ts] = *(const u32x4*)(xk + (kg * 8 + q) * 32 + ts * 16 * 1024);
#pragma unroll
                for (int q = 0; q < 8; ++q) {
                    const int ks = kg * 8 + q;
                    bf16x8 xh[2];
#pragma unroll
                    for (int ts = 0; ts < 2; ++ts) {
#pragma unroll
                        for (int e = 0; e < 4; ++e) { const float a_ = lo2f(xv[q][ts][e]), b_ = hi2f(xv[q][ts][e]); ssq[ts] += a_ * a_ + b_ * b_; }
                        xh[ts] = *reinterpret_cast<bf16x8*>(&xv[q][ts]);
                    }
#pragma unroll
                    for (int s_ = 0; s_ < 3; ++s_) {
                        const int off = (s_ * 16 + fr) * 1024 + (((ks * 4 + fq) ^ fr) * 16);
                        const bf16x8 wh = *(const LAS bf16x8*)(lds + RT_WH + off), wl = *(const LAS bf16x8*)(lds + RT_WL + off);
#pragma unroll
                        for (int ts = 0; ts < 2; ++ts) {
                            acc[s_][ts] = __builtin_amdgcn_mfma_f32_16x16x32_bf16(wh, xh[ts], acc[s_][ts], 0, 0, 0);
                            acc[s_][ts] = __builtin_amdgcn_mfma_f32_16x16x32_bf16(wl, xh[ts], acc[s_][ts], 0, 0, 0);
                        }
                    }
                }
            }
            __syncthreads();
        }
        int e1[2], e2[2]; unsigned r1[2] = {0u, 0u}, r2[2] = {0u, 0u}; float w1[2], w2[2]; bool mine[2];
#pragma unroll
        for (int ts = 0; ts < 2; ++ts) {
            float sst = ssq[ts]; sst += __shfl_xor(sst, 16); sst += __shfl_xor(sst, 32);
            const float rstd = rsqrtf(sst * (1.f / 1024.f) + EPS);
            const float l0 = acc[2][ts][0] * rstd + cj[32 + fq * 4 + 0], l1 = acc[2][ts][1] * rstd + cj[32 + fq * 4 + 1];
            const float l2 = acc[2][ts][2] * rstd + cj[32 + fq * 4 + 2], l3 = acc[2][ts][3] * rstd + cj[32 + fq * 4 + 3];
            int gi = 0; float gm = l0;
            if (l1 > gm) { gm = l1; gi = 1; }
            if (l2 > gm) { gm = l2; gi = 2; }
            if (l3 > gm) { gm = l3; gi = 3; }
            const float gs = __expf(l0 - gm) + __expf(l1 - gm) + __expf(l2 - gm) + __expf(l3 - gm);
            const float gw = 1.f / gs;
            float el[8];
#pragma unroll
            for (int j = 0; j < 4; ++j) { el[j] = acc[0][ts][j] * rstd + cj[fq * 4 + j]; el[4 + j] = acc[1][ts][j] * rstd + cj[16 + fq * 4 + j]; }
            int i1 = 0; float m1 = el[0];
#pragma unroll
            for (int i = 1; i < 8; ++i) if (el[i] > m1) { m1 = el[i]; i1 = i; }
            int i2 = -1; float m2 = -3.0e38f;
#pragma unroll
            for (int i = 0; i < 8; ++i) if (i != i1 && el[i] > m2) { m2 = el[i]; i2 = i; }
            const float ex = __expf(m2 - m1);
            const float p1 = 1.f / (1.f + ex), p2 = ex / (1.f + ex);
            mine[ts] = (fq == gi);
            e1[ts] = gi * 8 + i1; e2[ts] = gi * 8 + i2; w1[ts] = gw * p1; w2[ts] = gw * p2;
            if (mine[ts]) {
                r1[ts] = __hip_atomic_fetch_add(&lcnt[e1[ts]], 1u, __ATOMIC_RELAXED, __HIP_MEMORY_SCOPE_WORKGROUP);
                r2[ts] = __hip_atomic_fetch_add(&lcnt[e2[ts]], 1u, __ATOMIC_RELAXED, __HIP_MEMORY_SCOPE_WORKGROUP);
            }
        }
        __syncthreads();
        if (tid < 32) { const unsigned c = lcnt[tid]; lcnt[32 + tid] = c ? atomicAdd((unsigned*)(ws + WS_CTL) + CW_CNT + l * 32 + tid, c) : 0u; }
        __syncthreads();
#pragma unroll
        for (int ts = 0; ts < 2; ++ts) {
            if (mine[ts]) {
                const int t = blk * 256 + wave * 32 + ts * 16 + fr;
                int4* rt = (int4*)(ws + WS_ROUTE) + (size_t)t * 2;
                rt[0] = make_int4(e1[ts], (int)(lcnt[32 + e1[ts]] + r1[ts]), __float_as_int(w1[ts]), 0);
                rt[1] = make_int4(e2[ts], (int)(lcnt[32 + e2[ts]] + r2[ts]), __float_as_int(w2[ts]), 0);
            }
        }
        {
            float gs[16], sv[16];
            norm_consts(g2, mod + 3 * 1024, mod + 4 * 1024, b, lane, gs, sv);
            unsigned char* H = ws + WS_H;
#pragma unroll 1
            for (int r = 0; r < 32; r += 4) {
                const int t = blk * 256 + wave * 32 + r;
                float xq[4][16];
#pragma unroll
                for (int q = 0; q < 4; ++q)
#pragma unroll
                    for (int i = 0; i < 4; ++i) { const u32x2 v = *(const u32x2*)(x + (size_t)(t + q) * 1024 + i * 256 + lane * 4); xq[q][i * 4] = lo2f(v[0]); xq[q][i * 4 + 1] = hi2f(v[0]); xq[q][i * 4 + 2] = lo2f(v[1]); xq[q][i * 4 + 3] = hi2f(v[1]); }
#pragma unroll
                for (int q = 0; q < 4; ++q) norm_store_row_f8(H + (size_t)(t + q) * 1024, lane, xq[q], gs, sv);
            }
        }
        __syncthreads();
    }
}

constexpr bool G_SP2 = true, G_ALIGN = true;
constexpr int G_HTB = 128 * 64 * 2, G_STAGE_BYTES = 8 * G_HTB;
constexpr int LDS_POFF = G_STAGE_BYTES;
DEVINL int g_lds_byte(int r, int c) { const int st = (r >> 4) * 2 + (c >> 5), rr = r & 15, cc = c & 31, ob = rr * 64 + cc * 2; return st * 1024 + (ob ^ (((ob >> 9) & 1) << 5)); }
DEVINL void g_stage_rc(int b, int& R, int& C) { const int st = b / 1024, sb = b % 1024, swz = sb ^ (((sb >> 9) & 1) << 5); R = (st >> 1) * 16 + swz / 64; C = (st & 1) * 32 + (swz % 64) / 2; }
struct GUnit { const char* a; const char* b; int pm, pn, sub; };
DEVINL void g_tile_order(int L, int nM, int nN, int& pm, int& pn) {
    const int nwg = nM * nN; int wgid = L;
    { const int q = nwg / 8, r = nwg % 8, xcd = wgid % 8, off = wgid / 8; wgid = (xcd < r ? xcd * (q + 1) : r * (q + 1) + (xcd - r) * q) + off; }
    const int nig = 8 * nN, gid = wgid / nig, fm = gid * 8, gsz = (nM - fm) < 8 ? (nM - fm) : 8;
    pm = fm + ((wgid % nig) % gsz); pn = (wgid % nig) / gsz;
}
struct DenseSched {
    const char* A; const char* B; int lda, ldb, nM, nN; unsigned long long pnmap;
    DEVINL bool next(int i, GUnit& u) const {
        const int L = i * (int)gridDim.x + BID(); if (L >= nM * nN) return false;
        g_tile_order(L, nM, nN, u.pm, u.pn); u.sub = 0;
        if (pnmap) u.pn = (int)((pnmap >> (4 * u.pn)) & 15ull);
        u.a = A + (size_t)u.pm * 256 * lda * 2; u.b = B + (size_t)u.pn * 256 * ldb * 2; return true;
    }
};
struct SplitSched {
    const char* A; const char* A2; const char* B; int lda, ldb, nM, nN, pm_split;
    DEVINL bool next(int i, GUnit& u) const {
        const int L = i * (int)gridDim.x + BID(); if (L >= nM * nN) return false;
        g_tile_order(L, nM, nN, u.pm, u.pn); u.sub = 0;
        u.a = (u.pm < pm_split ? A + (size_t)u.pm * 256 * lda * 2 : A2 + (size_t)(u.pm - pm_split) * 256 * lda * 2); u.b = B + (size_t)u.pn * 256 * ldb * 2; return true;
    }
};
struct MoeSched {
    const char* A; const char* B; int lda, ldb; size_t bstride; LAS const int* poff;
    DEVINL bool next(int i, GUnit& u) const {
        const int L = i * (int)gridDim.x + BID(); const int ntm = __builtin_amdgcn_readfirstlane(poff[32]) >> 8; if (L >= ntm * 4) return false;
        u.pm = L >> 2; u.pn = L & 3; const int m0 = u.pm << 8; int e = 0;
        for (int q = 1; q < 32; ++q) { const int pq = __builtin_amdgcn_readfirstlane(poff[q]); if (m0 >= pq) e = q; }
        u.sub = e; u.a = A + (size_t)u.pm * 256 * lda * 2; u.b = B + (size_t)e * bstride + (size_t)u.pn * 256 * ldb * 2; return true;
    }
};
struct MoeGatherSched {
    const char* A; const char* B; int ldb; size_t bstride; LAS const int* poff; const int* tokl;
    DEVINL int tok(int row) const { return tokl[row]; }
    DEVINL bool next(int i, GUnit& u) const {
        const int L = i * (int)gridDim.x + BID(); const int ntm = __builtin_amdgcn_readfirstlane(poff[32]) >> 8; if (L >= ntm * 4) return false;
        u.pm = L >> 2; u.pn = L & 3; const int m0 = u.pm << 8; int e = 0;
        for (int q = 1; q < 32; ++q) { const int pq = __builtin_amdgcn_readfirstlane(poff[q]); if (m0 >= pq) e = q; }
        u.sub = e; u.a = A; u.b = B + (size_t)e * bstride + (size_t)u.pn * 256 * ldb * 2; return true;
    }
};
struct BranchSched {
    const char* Y0; const char* Y1; const char* Y2; const char* B;
    DEVINL bool next(int i, GUnit& u) const {
        const int tile = (i / 3) * (int)gridDim.x + BID(); if (tile >= 1024) return false;
        u.sub = i % 3; g_tile_order(tile, 256, 4, u.pm, u.pn);
        const char* y = u.sub == 0 ? Y0 : (u.sub == 1 ? Y1 : Y2);
        u.a = y + (size_t)u.pm * 256 * 512 * 2; u.b = B + (size_t)u.sub * 1024 * 512 * 2 + (size_t)u.pn * 256 * 512 * 2; return true;
    }
};

template <bool TR, bool GATHER, bool SP2, bool ALIGN, bool F8, class Sched, class Epi>
DEVINL void gemm_phase_t(LAS unsigned char* lds, const Sched& S, const Epi& E, int lda, int ldb, int K) {
    const int tid = TID(), wid = __builtin_amdgcn_readfirstlane(tid >> 6), lane = tid & 63, wr = wid >> 2, wc = wid & 3, fr = lane & 15, fq = lane >> 4;
    const int nt = K / 64;
    unsigned voffA[2], voffB[2];
#pragma unroll
    for (int i = 0; i < 2; ++i) { int R, C; g_stage_rc(tid * 16 + i * 8192, R, C);
        const int Ra = TR ? ((R & ~31) + 8 * ((R & 15) >> 2) + 4 * ((R >> 4) & 1) + (R & 3)) : R;
        voffA[i] = (unsigned)(Ra * lda + C) * 2u; voffB[i] = (unsigned)(R * ldb + C) * 2u; }
    const size_t kstep = 128, hstepA = GATHER ? 0 : (size_t)128 * lda * 2, hstepB = (size_t)128 * ldb * 2;
    unsigned gA[2][2] = {{0u, 0u}, {0u, 0u}}, gN[2][2] = {{0u, 0u}, {0u, 0u}};
#define PG8_TOK(dst, un) do { if constexpr (GATHER) { _Pragma("unroll") for (int h_ = 0; h_ < 2; ++h_) _Pragma("unroll") for (int i_ = 0; i_ < 2; ++i_) { int R_, C_; g_stage_rc(tid * 16 + i_ * 8192, R_, C_); \
        dst[h_][i_] = ((unsigned)S.tok((un).pm * 256 + h_ * 128 + R_) * (unsigned)lda + (unsigned)C_) * 2u; } } } while (0)
#define VA0(nx) (GATHER ? ((nx) ? gN[0] : gA[0]) : voffA)
#define VA1(nx) (GATHER ? ((nx) ? gN[1] : gA[1]) : voffA)
    const unsigned ldsw = (unsigned)wid * 1024u;
    const int aoff = g_lds_byte(wr * 64 + fr, fq * 8), boff = g_lds_byte(wc * 32 + fr, fq * 8);
#define PG8_SA(b, h) (((b) * 2 + (h)) * G_HTB)
#define PG8_SB(b, h) ((4 + (b) * 2 + (h)) * G_HTB)
#define PG8_STAGE(bufoff, gbase, voff) do { _Pragma("unroll") for (int _i = 0; _i < 2; ++_i) \
        __builtin_amdgcn_global_load_lds((const unsigned*)((const char*)(gbase) + (voff)[_i]), (LAS unsigned*)(lds + (bufoff) + ldsw + _i * 8192), 16, 0, 0); } while (0)
#define PG8_LDA(dst, b, h) do { if constexpr (F8) { _Pragma("unroll") for (int m = 0; m < 4; ++m) { const v4i lo_ = *(const LAS v4i*)(lds + PG8_SA(b, h) + aoff + m * 2048), hi_ = *(const LAS v4i*)(lds + PG8_SA(b, h) + aoff + m * 2048 + 1024); \
        dst##8[m] = __builtin_shufflevector(lo_, hi_, 0, 1, 2, 3, 4, 5, 6, 7); } } else { _Pragma("unroll") for (int m = 0; m < 4; ++m) _Pragma("unroll") for (int k = 0; k < 2; ++k) dst[m][k] = *(const LAS bf16x8*)(lds + PG8_SA(b, h) + aoff + m * 2048 + k * 1024); } } while (0)
#define PG8_LDB(dst, b, h) do { if constexpr (F8) { _Pragma("unroll") for (int n = 0; n < 2; ++n) { const v4i lo_ = *(const LAS v4i*)(lds + PG8_SB(b, h) + boff + n * 2048), hi_ = *(const LAS v4i*)(lds + PG8_SB(b, h) + boff + n * 2048 + 1024); \
        dst##8[n] = __builtin_shufflevector(lo_, hi_, 0, 1, 2, 3, 4, 5, 6, 7); } } else { _Pragma("unroll") for (int n = 0; n < 2; ++n) _Pragma("unroll") for (int k = 0; k < 2; ++k) dst[n][k] = *(const LAS bf16x8*)(lds + PG8_SB(b, h) + boff + n * 2048 + k * 1024); } } while (0)
#define PG8_MMA(ai, bj, At, Bt) do { __builtin_amdgcn_s_setprio(1); if constexpr (F8) { _Pragma("unroll") for (int m = 0; m < 4; ++m) _Pragma("unroll") for (int n = 0; n < 2; ++n) \
        asm volatile("v_mfma_f32_16x16x128_f8f6f4 %0, %1, %2, %0" : "+v"(acc[ai][bj][m][n]) : "v"(Bt##8[n]), "v"(At##8[m])); } else \
        _Pragma("unroll") for (int m = 0; m < 4; ++m) _Pragma("unroll") for (int n = 0; n < 2; ++n) _Pragma("unroll") for (int k = 0; k < 2; ++k) \
        acc[ai][bj][m][n] = TR ? __builtin_amdgcn_mfma_f32_16x16x32_bf16(At[m][k], Bt[n][k], acc[ai][bj][m][n], 0, 0, 0) : __builtin_amdgcn_mfma_f32_16x16x32_bf16(Bt[n][k], At[m][k], acc[ai][bj][m][n], 0, 0, 0); __builtin_amdgcn_s_setprio(0); } while (0)
#define PG8_WAIT_V(n) asm volatile("s_waitcnt vmcnt(" #n ")" ::: "memory")
#define PG8_WAIT_L(n) asm volatile("s_waitcnt lgkmcnt(" #n ")" ::: "memory")
#define PG8_BAR __builtin_amdgcn_s_barrier()
#define PG8_SCHED __builtin_amdgcn_sched_barrier(0)
    GUnit cur, nxt; int ui = 0;
    if (!S.next(0, cur)) return;
    f32x4 acc[2][2][4][2];
#pragma unroll
    for (int a = 0; a < 2; ++a)
#pragma unroll
        for (int b = 0; b < 2; ++b)
#pragma unroll
            for (int m = 0; m < 4; ++m)
#pragma unroll
                for (int n = 0; n < 2; ++n) acc[a][b][m][n] = (f32x4){0.f, 0.f, 0.f, 0.f};
    bf16x8 At[4][2], B0[2][2], B1[2][2];
    v8i At8[4], B08[2], B18[2];
    const char* cA = cur.a; const char* cB = cur.b;
    PG8_TOK(gA, cur);
    if constexpr (SP2) {
        PG8_STAGE(PG8_SB(0, 0), cB, voffB); PG8_STAGE(PG8_SB(0, 1), cB + hstepB, voffB); PG8_STAGE(PG8_SA(0, 0), cA, VA0(false)); PG8_STAGE(PG8_SA(0, 1), cA + hstepA, VA1(false));
        if (wr == 1) PG8_BAR;
        PG8_WAIT_V(2); PG8_BAR;
        PG8_STAGE(PG8_SB(1, 0), cB + kstep, voffB); PG8_STAGE(PG8_SA(1, 0), cA + kstep, VA0(false)); PG8_STAGE(PG8_SB(1, 1), cB + hstepB + kstep, voffB);
        PG8_WAIT_V(6); PG8_BAR;
    } else {
    PG8_STAGE(PG8_SB(0, 0), cB, voffB); PG8_STAGE(PG8_SA(0, 0), cA, VA0(false)); PG8_STAGE(PG8_SB(0, 1), cB + hstepB, voffB); PG8_STAGE(PG8_SA(0, 1), cA + hstepA, VA1(false));
    if (wr == 1) PG8_BAR;
    PG8_WAIT_V(4); PG8_BAR;
    PG8_STAGE(PG8_SB(1, 0), cB + kstep, voffB); PG8_STAGE(PG8_SA(1, 0), cA + kstep, VA0(false)); PG8_STAGE(PG8_SB(1, 1), cB + hstepB + kstep, voffB);
    PG8_WAIT_V(6); PG8_BAR;
    }
    for (;;) {
        const bool has_next = S.next(ui + 1, nxt);
        const char* nA = has_next ? nxt.a : cA; const char* nB = has_next ? nxt.b : cB;
        if (GATHER) { if (has_next) PG8_TOK(gN, nxt); else { gN[0][0] = gA[0][0]; gN[0][1] = gA[0][1]; gN[1][0] = gA[1][0]; gN[1][1] = gA[1][1]; } }
#pragma unroll 1
        for (int t = 0; t < nt; t += 2) {
            const bool last = (t == nt - 2);
            const char* a1 = cA + (size_t)(t + 1) * kstep;
            const char* a2 = last ? nA : cA + (size_t)(t + 2) * kstep; const char* b2 = last ? nB : cB + (size_t)(t + 2) * kstep;
            const char* a3 = a2 + kstep; const char* b3 = b2 + kstep;
            if constexpr (SP2) {
            PG8_LDB(B0, 0, 0); PG8_LDB(B1, 0, 1); PG8_SCHED; PG8_LDA(At, 0, 0); PG8_STAGE(PG8_SA(1, 1), a1 + hstepA, VA1(false));
            PG8_WAIT_V(8); PG8_WAIT_L(0); PG8_BAR; PG8_MMA(0, 0, At, B0); PG8_MMA(0, 1, At, B1); PG8_BAR; PG8_SCHED;
            PG8_LDA(At, 0, 1); PG8_STAGE(PG8_SB(0, 0), b2, voffB); PG8_STAGE(PG8_SB(0, 1), b2 + hstepB, voffB); PG8_STAGE(PG8_SA(0, 0), a2, VA0(last));
            PG8_WAIT_V(8); PG8_WAIT_L(0); PG8_BAR; PG8_MMA(1, 0, At, B0); PG8_MMA(1, 1, At, B1); PG8_BAR; PG8_SCHED;
            PG8_LDB(B0, 1, 0); PG8_LDB(B1, 1, 1); PG8_SCHED; PG8_LDA(At, 1, 0); PG8_STAGE(PG8_SA(0, 1), a2 + hstepA, VA1(last));
            PG8_WAIT_V(8); PG8_WAIT_L(0); PG8_BAR; PG8_MMA(0, 0, At, B0); PG8_MMA(0, 1, At, B1); PG8_BAR; PG8_SCHED;
            PG8_LDA(At, 1, 1); PG8_STAGE(PG8_SB(1, 0), b3, voffB); PG8_STAGE(PG8_SB(1, 1), b3 + hstepB, voffB); PG8_STAGE(PG8_SA(1, 0), a3, VA0(last));
            PG8_WAIT_V(8); PG8_WAIT_L(0); PG8_BAR; PG8_MMA(1, 0, At, B0); PG8_MMA(1, 1, At, B1); PG8_BAR; PG8_SCHED;
            } else {
            PG8_LDB(B0, 0, 0); PG8_SCHED; PG8_LDA(At, 0, 0); PG8_STAGE(PG8_SA(1, 1), a1 + hstepA, VA1(false));
            PG8_WAIT_L(8); PG8_BAR; PG8_WAIT_L(0); PG8_MMA(0, 0, At, B0); PG8_BAR; PG8_SCHED;
            PG8_LDB(B1, 0, 1); PG8_STAGE(PG8_SB(0, 0), b2, voffB);
            PG8_BAR; PG8_WAIT_L(0); PG8_MMA(0, 1, At, B1); PG8_BAR;
            PG8_LDA(At, 0, 1); PG8_STAGE(PG8_SA(0, 0), a2, VA0(last));
            PG8_BAR; PG8_WAIT_L(0); PG8_MMA(1, 0, At, B0); PG8_BAR; PG8_SCHED;
            PG8_STAGE(PG8_SB(0, 1), b2 + hstepB, voffB);
            PG8_WAIT_V(6); PG8_BAR; PG8_MMA(1, 1, At, B1); PG8_BAR;
            PG8_LDB(B0, 1, 0); PG8_SCHED; PG8_LDA(At, 1, 0); PG8_STAGE(PG8_SA(0, 1), a2 + hstepA, VA1(last));
            PG8_WAIT_L(8); PG8_BAR; PG8_WAIT_L(0); PG8_MMA(0, 0, At, B0); PG8_BAR; PG8_SCHED;
            PG8_LDB(B1, 1, 1); PG8_STAGE(PG8_SB(1, 0), b3, voffB);
            PG8_BAR; PG8_WAIT_L(0); PG8_MMA(0, 1, At, B1); PG8_BAR;
            PG8_LDA(At, 1, 1); PG8_STAGE(PG8_SA(1, 0), a3, VA0(last));
            PG8_BAR; PG8_WAIT_L(0); PG8_MMA(1, 0, At, B0); PG8_BAR; PG8_SCHED;
            PG8_STAGE(PG8_SB(1, 1), b3 + hstepB, voffB);
            PG8_WAIT_V(6); PG8_BAR; PG8_MMA(1, 1, At, B1); PG8_BAR;
                    }
        }
        if constexpr (F8) asm volatile("s_nop 15\n\ts_nop 15" ::: "memory");
        if constexpr (ALIGN) { if (wr == 0) PG8_BAR; }
        E(acc, cur, wr, wc, fr, fq);
        if (!has_next) break;
        if (!E.keep(cur))
#pragma unroll
        for (int a = 0; a < 2; ++a)
#pragma unroll
            for (int b = 0; b < 2; ++b)
#pragma unroll
                for (int m = 0; m < 4; ++m)
#pragma unroll
                    for (int n = 0; n < 2; ++n) acc[a][b][m][n] = (f32x4){0.f, 0.f, 0.f, 0.f};
        cur = nxt; cA = nA; cB = nB; ++ui;
        if (GATHER) { gA[0][0] = gN[0][0]; gA[0][1] = gN[0][1]; gA[1][0] = gN[1][0]; gA[1][1] = gN[1][1]; }
        if constexpr (ALIGN) { if (wr == 1) PG8_BAR; }
    }
    PG8_WAIT_V(0);
    if constexpr (!ALIGN) { if (wr == 0) PG8_BAR; }
    PG8_BAR;
#undef PG8_TOK
#undef VA0
#undef VA1
#undef PG8_SA
#undef PG8_SB
#undef PG8_STAGE
#undef PG8_LDA
#undef PG8_LDB
#undef PG8_MMA
#undef PG8_WAIT_V
#undef PG8_WAIT_L
#undef PG8_BAR
#undef PG8_SCHED
}
template <class Sched, class Epi> DEVINL void gemm_phase(LAS unsigned char* lds, const Sched& S, const Epi& E, int lda, int ldb, int K) { gemm_phase_t<false, false, G_SP2, G_ALIGN, false>(lds, S, E, lda, ldb, K); }
DEVINL void st4bf(u16* dst, f32x4 v) { u32x2 o = {pk2(v[0], v[1]), pk2(v[2], v[3])}; *(u32x2*)dst = o; }
DEVINL void st8bf(u16* dst, f32x4 a, f32x4 b) { u32x4 o = {pk2(a[0], a[1]), pk2(a[2], a[3]), pk2(b[0], b[1]), pk2(b[2], b[3])}; *(u32x4*)dst = o; }
typedef f32x4 GAcc[2][2][4][2];
#define G_ROW(u, ai, m) ((u).pm * 256 + (ai) * 128 + wr * 64 + (m) * 16 + fr)
#define G_RUN(u, bj) ((u).pn * 256 + (bj) * 128 + wc * 32)

struct EpiProj {
    unsigned char* ws;
    DEVINL bool keep(const GUnit&) const { return false; }
    DEVINL void operator()(const GAcc& acc, const GUnit& u, int wr, int wc, int fr, int fq) const {
#pragma unroll
        for (int bj = 0; bj < 2; ++bj) {
            const int cb = G_RUN(u, bj);
            u16* dst; int ld, c0;
            if (cb < 512) { dst = (u16*)(ws + WS_RQK); ld = 512; c0 = cb; }
            else if (cb < 1024) { dst = (u16*)(ws + WS_RV); ld = 512; c0 = cb - 512; }
            else if (cb < 1536) { dst = (u16*)(ws + WS_RG); ld = 512; c0 = cb - 1024; }
            else if (cb < 2048) { dst = (u16*)(ws + WS_FQ); ld = 512; c0 = cb - 1536; }
            else if (cb < 2560) { dst = (u16*)(ws + WS_FK); ld = 512; c0 = cb - 2048; }
            else if (cb < 3072) { dst = (u16*)(ws + WS_FV); ld = 512; c0 = cb - 2560; }
            else if (cb < 3328) { dst = (u16*)(ws + WS_MQ); ld = 256; c0 = cb - 3072; }
            else if (cb < 3456) { dst = (u16*)(ws + WS_MKV); ld = 128; c0 = cb - 3328; }
            else if (cb < 3520) { dst = (u16*)(ws + WS_KPE); ld = 64; c0 = cb - 3456; }
            else { dst = nullptr; ld = 0; c0 = 0; }
            const bool roped = (cb < 512) || (cb >= 3456 && cb < 3520);
            if (dst && roped) {
                const int g = (cb >> 5) & 1, hb = c0 & ~63, i0 = 16 * g + 4 * fq;
                const float2* tab = (const float2*)(ws + WS_ROPE);
#pragma unroll
                for (int ai = 0; ai < 2; ++ai)
#pragma unroll
                    for (int m = 0; m < 4; ++m) {
                        int row = G_ROW(u, ai, m); asm volatile("" : "+v"(row));
                        const float4 t0 = *(const float4*)(tab + (size_t)row * 32 + i0), t1 = *(const float4*)(tab + (size_t)row * 32 + i0 + 2);
                        const f32x4 x1 = acc[ai][bj][m][0], x2 = acc[ai][bj][m][1];
                        f32x4 y1, y2;
                        y1[0] = x1[0] * t0.x - x2[0] * t0.y; y2[0] = x2[0] * t0.x + x1[0] * t0.y;
                        y1[1] = x1[1] * t0.z - x2[1] * t0.w; y2[1] = x2[1] * t0.z + x1[1] * t0.w;
                        y1[2] = x1[2] * t1.x - x2[2] * t1.y; y2[2] = x2[2] * t1.x + x1[2] * t1.y;
                        y1[3] = x1[3] * t1.z - x2[3] * t1.w; y2[3] = x2[3] * t1.z + x1[3] * t1.w;
                        u16* rp = dst + (size_t)row * ld + hb + i0;
                        st4bf(rp, y1); st4bf(rp + 32, y2);
                        asm volatile("" ::: "memory");
                    }
            } else if (dst) {
#pragma unroll
                for (int ai = 0; ai < 2; ++ai)
#pragma unroll
                    for (int m = 0; m < 4; ++m) {
                        st8bf(dst + (size_t)G_ROW(u, ai, m) * ld + c0 + fq * 8, acc[ai][bj][m][0], acc[ai][bj][m][1]);
                    }
            } else if (cb == 3520 && fq == 0) {
                float* ffl = (float*)(ws + WS_FFL);
#pragma unroll
                for (int ai = 0; ai < 2; ++ai)
#pragma unroll
                    for (int m = 0; m < 4; ++m) *(f32x4*)(ffl + (size_t)G_ROW(u, ai, m) * 4) = acc[ai][bj][m][0];
            }
        }
    }
};
struct EpiVT { u16* dst; int col0; u16* dst2; int col2; int pn_split;
    DEVINL bool keep(const GUnit&) const { return false; }
    DEVINL void operator()(const GAcc& acc, const GUnit& u, int wr, int wc, int fr, int fq) const {
        const int b = u.pm >> 4, s0 = (u.pm & 15) * 256;
        u16* d = u.pn >= pn_split ? dst2 : dst; const int c0 = u.pn >= pn_split ? col2 : col0;
#pragma unroll
        for (int bj = 0; bj < 2; ++bj)
#pragma unroll
            for (int n = 0; n < 2; ++n) {
                const int eg = u.pn * 256 + bj * 128 + wc * 32 + n * 16 + fr - c0;
                u16* rp = d + ((size_t)(b * 4 + (eg >> 7)) * 128 + (eg & 127)) * 4096 + s0 + wr * 64 + fq * 8;
#pragma unroll
                for (int ai = 0; ai < 2; ++ai)
#pragma unroll
                    for (int g = 0; g < 2; ++g) st8bf(rp + ai * 128 + g * 32, acc[ai][bj][2 * g][n], acc[ai][bj][2 * g + 1][n]);
            }
    }
};
struct EpiVT8 { unsigned char* dst;
    DEVINL bool keep(const GUnit&) const { return false; }
    DEVINL void operator()(const GAcc& acc, const GUnit& u, int wr, int wc, int fr, int fq) const {
        const int b = u.pm >> 4, s0 = (u.pm & 15) * 256;
#pragma unroll
        for (int bj = 0; bj < 2; ++bj)
#pragma unroll
            for (int n = 0; n < 2; ++n) {
                const int eg = u.pn * 256 + bj * 128 + wc * 32 + n * 16 + fr - 512;
                unsigned char* rp = dst + ((size_t)(b * 4 + (eg >> 7)) * 128 + (eg & 127)) * 4096 + s0 + wr * 64 + fq * 8;
#pragma unroll
                for (int ai = 0; ai < 2; ++ai)
#pragma unroll
                    for (int g = 0; g < 2; ++g) {
                        const f32x4 a0 = acc[ai][bj][2 * g][n], a1 = acc[ai][bj][2 * g + 1][n];
                        const u32x2 o = {pk4_f8(a0[0], a0[1], a0[2], a0[3]), pk4_f8(a1[0], a1[1], a1[2], a1[3])};
                        *(u32x2*)(rp + ai * 128 + g * 32) = o;
                    }
            }
    }
};
DEVINL void ph_gemm_in(const Params& p, LAS unsigned char* lds) {
    unsigned char* ws = WSP(p);
    { DenseSched SV{(const char*)(ws + WS_H), (const char*)(ws + WS_WIN), 1024, 1024, 256, 4, 0xBA32ull};
      gemm_phase_t<true, false, G_SP2, G_ALIGN, false>(lds, SV, EpiVT{(u16*)(ws + WS_RV), 512, (u16*)(ws + WS_FV), 2560, 8}, 1024, 1024, 1024); }
    DenseSched S{(const char*)(ws + WS_H), (const char*)(ws + WS_WIN), 1024, 1024, 256, 10, 0xDC98765410ull};
    gemm_phase(lds, S, EpiProj{ws}, 1024, 1024, 1024);
}
struct EpiStore { unsigned char* dst;
    DEVINL bool keep(const GUnit&) const { return false; }
    DEVINL void operator()(const GAcc& acc, const GUnit& u, int wr, int wc, int fr, int fq) const {
#pragma unroll
        for (int ai = 0; ai < 2; ++ai)
#pragma unroll
            for (int m = 0; m < 4; ++m)
#pragma unroll
                for (int bj = 0; bj < 2; ++bj) {
                    const int cb = G_RUN(u, bj), hh = cb >> 7, dc = (cb >> 5) & 3;
                    const f32x4 a0 = acc[ai][bj][m][0], a1 = acc[ai][bj][m][1];
                    const u32x2 o = {pk4_f8(a0[0], a0[1], a0[2], a0[3]), pk4_f8(a1[0], a1[1], a1[2], a1[3])};
                    *(u32x2*)(dst + (size_t)G_ROW(u, ai, m) * 512 + hh * 128 + (dc >> 1) * 64 + fq * 16 + (dc & 1) * 8) = o;
                }
    }
};
template <int W>
DEVINL void rmsnorm_inplace(u16* buf, const float* g) {
    const int lane = TID() & 63, gw = blockIdx.x * 8 + (TID() >> 6), GW = gridDim.x * 8;
    constexpr int PER = W / 64;
    float gl[PER];
#pragma unroll
    for (int i = 0; i < PER; ++i) gl[i] = g[lane * PER + i];
    for (int t = gw * 4; t < T_; t += GW * 4) {
        float v[4][PER];
#pragma unroll
        for (int q = 0; q < 4; ++q) {
            const u16* r = buf + (size_t)(t + q) * W + lane * PER;
            if constexpr (PER == 4) { const u32x2 w = *(const u32x2*)r; v[q][0] = lo2f(w[0]); v[q][1] = hi2f(w[0]); v[q][2] = lo2f(w[1]); v[q][3] = hi2f(w[1]); }
            else { const unsigned w = *(const unsigned*)r; v[q][0] = lo2f(w); v[q][1] = hi2f(w); }
        }
#pragma unroll
        for (int q = 0; q < 4; ++q) {
            float ss = 0.f;
#pragma unroll
            for (int i = 0; i < PER; ++i) ss += v[q][i] * v[q][i];
            ss = wsum(ss);
            const float rstd = rsqrtf(ss * (1.f / W) + EPS);
            u16* r = buf + (size_t)(t + q) * W + lane * PER;
            if constexpr (PER == 4) { const u32x2 o = {pk2(v[q][0] * rstd * gl[0], v[q][1] * rstd * gl[1]), pk2(v[q][2] * rstd * gl[2], v[q][3] * rstd * gl[3])}; *(u32x2*)r = o; }
            else *(unsigned*)r = pk2(v[q][0] * rstd * gl[0], v[q][1] * rstd * gl[1]);
        }
    }
}
DEVINL void ph_fcum(const Params& p, int l, LAS unsigned char* lds) {
    const int tid = TID(), lane = tid & 63, wave = tid >> 6;
    const float* ffl = (const float*)(WSP(p) + WS_FFL);
    float* fc = (float*)(WSP(p) + WS_FCUM);
    LAS float* wt = (LAS float*)lds;
    for (int bh = blockIdx.x; bh < 64; bh += gridDim.x) {
        const int b = bh >> 2, h = bh & 3;
        const float fb = p.in[I_FOXFB][l * 4 + h];
        float x[8], vals[8];
#pragma unroll
        for (int c = 0; c < 8; ++c) x[c] = ffl[((size_t)b * 4096 + (wave * 8 + c) * 64 + lane) * 4 + h] + fb;
        float carry = 0.f;
#pragma unroll
        for (int c = 0; c < 8; ++c) {
            float v = fminf(x[c], 0.f) - log1pf(__expf(-fabsf(x[c])));
#pragma unroll
            for (int o = 1; o < 64; o <<= 1) { const float n = __shfl_up(v, o); if (lane >= o) v += n; }
            vals[c] = carry + v;
            carry += __shfl(v, 63);
        }
        __syncthreads();
        if (lane == 0) wt[wave] = carry;
        __syncthreads();
        float off = 0.f;
        for (int w2 = 0; w2 < wave; ++w2) off += wt[w2];
#pragma unroll
        for (int c = 0; c < 8; ++c) fc[(size_t)bh * 4096 + (wave * 8 + c) * 64 + lane] = off + vals[c];
    }
}

DEVINL void retention_unit(const Params& p, LAS unsigned char* lds, const int bh) {
    unsigned char* ws = WSP(p);
    const int tid = TID(), lane = tid & 63, wave = __builtin_amdgcn_readfirstlane(tid >> 6), fr_ = lane & 15, fq_ = lane >> 4;
    constexpr int KIMG = 0, KTIMG = 16384, VTIMG = 32768, STIMG = 65536;
    const u16* RQK = (const u16*)(ws + WS_RQK); const u16* RVT = (const u16*)(ws + WS_RVT); u16* RG = (u16*)(ws + WS_RG);
    const int st_ = tid >> 2;
    const int skc = (tid & 3) * 2, svc = (tid & 3) * 4;
    const int qloc = wave * 16 + fr_;
    const int ncc = (wave >> 1) + 1;
    {
        const int b = bh >> 2, h = bh & 3;
        const float lg = (h == 0) ? -0.04580368961312479f : (h == 1) ? -0.02272007650008353f : (h == 2) ? -0.011315313227834146f : -0.005646563141142063f;
        const float g128 = __builtin_amdgcn_exp2f(128.f * lg);
        const float kfac = __builtin_amdgcn_exp2f((float)(127 - st_) * lg) * 0.125f;
        const float qdec = __builtin_amdgcn_exp2f((float)(qloc + 1) * lg);
        f32x4 S[4];
#pragma unroll
        for (int dt = 0; dt < 4; ++dt) S[dt] = f32x4{0.f, 0.f, 0.f, 0.f};
        { u32x4 z4 = {0u, 0u, 0u, 0u}; asm volatile("" : "+v"(z4));
          for (int i = tid; i < 16384 / 16; i += NTHR) *(LAS u32x4*)(lds + STIMG + i * 16) = z4; }
        const size_t seq0 = (size_t)b * 4096;
        bf16x8 kreg[2], vreg[4], qf[2];
#define RET_LOAD(n_) do { const size_t r_ = seq0 + (size_t)(n_) * 128; \
            _Pragma("unroll") for (int i = 0; i < 2; ++i) kreg[i] = *(const bf16x8*)(RQK + (r_ + st_) * 512 + 256 + h * 64 + (skc + i) * 8); \
            _Pragma("unroll") for (int i = 0; i < 4; ++i) vreg[i] = *(const bf16x8*)(RVT + ((size_t)bh * 128 + st_) * 4096 + (size_t)(n_) * 128 + (svc + i) * 8); \
            _Pragma("unroll") for (int dc = 0; dc < 2; ++dc) qf[dc] = *(const bf16x8*)(RQK + (r_ + qloc) * 512 + h * 64 + dc * 32 + fq_ * 8); } while (0)
        RET_LOAD(0);
        for (int n = 0; n < 32; ++n) {
            const size_t row0 = seq0 + (size_t)n * 128;
            int st = st_, fr = fr_, fq = fq_;
            asm volatile("" : "+v"(st), "+v"(fr), "+v"(fq));
            const int lb0 = fr * 256 + ((fq ^ (fr & 3)) * 16);
            const int sb0 = fr * 128 + ((fq ^ ((fr >> 1) & 3)) * 16);
            const int kb0 = ((fr >> 2) * 8 + (fr & 3)) * 128 + ((fq ^ ((fr >> 1) & 3)) * 16);
            const int swzp = ((st >> 1) & 1) | (((st >> 3) & 3) << 1);
#pragma unroll
            for (int i = 0; i < 2; ++i) {
                const int c = skc + i;
                *(LAS bf16x8*)(lds + KIMG + st * 128 + ((c ^ swzp) * 16)) = kreg[i];
#pragma unroll
                for (int j = 0; j < 8; ++j) {
                    const int d = c * 8 + j;
                    *(LAS u16*)(lds + KTIMG + d * 256 + (((st >> 3) ^ (d & 15)) * 16) + (st & 7) * 2) = f2bf(kfac * bf2f((u16)kreg[i][j]));
                }
            }
#pragma unroll
            for (int i = 0; i < 4; ++i) {
                const int c = svc + i;
                *(LAS bf16x8*)(lds + VTIMG + st * 256 + ((c ^ (st & 15)) * 16)) = vreg[i];
            }
            const bf16x8 q0 = qf[0], q1 = qf[1];
            __syncthreads();
            if (n < 31) RET_LOAD(n + 1);
            bf16x8 pf[4];
#pragma unroll
            for (int cc = 0; cc < 4; ++cc) {
                if (cc < ncc) {
                    f32x4 s0 = f32x4{0.f, 0.f, 0.f, 0.f}, s1 = s0;
#pragma unroll
                    for (int dc = 0; dc < 2; ++dc) {
                        const int ka = kb0 + ((dc ^ (fr >> 3)) * 64);
                        const bf16x8 k0 = *(const LAS bf16x8*)(lds + ka + (KIMG + cc * 4096));
                        const bf16x8 k1 = *(const LAS bf16x8*)(lds + ka + (KIMG + cc * 4096 + 512));
                        s0 = __builtin_amdgcn_mfma_f32_16x16x32_bf16(k0, dc ? q1 : q0, s0, 0, 0, 0);
                        s1 = __builtin_amdgcn_mfma_f32_16x16x32_bf16(k1, dc ? q1 : q0, s1, 0, 0, 0);
                    }
                    float pv[8];
#pragma unroll
                    for (int jj = 0; jj < 4; ++jj) {
                        const int m0 = cc * 32 + fq * 8 + jj, m1 = m0 + 4;
                        pv[jj] = (m0 <= qloc) ? s0[jj] * 0.125f * __builtin_amdgcn_exp2f((float)(qloc - m0) * lg) : 0.f;
                        pv[4 + jj] = (m1 <= qloc) ? s1[jj] * 0.125f * __builtin_amdgcn_exp2f((float)(qloc - m1) * lg) : 0.f;
                    }
                    u32x4 w = {pk2(pv[0], pv[1]), pk2(pv[2], pv[3]), pk2(pv[4], pv[5]), pk2(pv[6], pv[7])};
                    pf[cc] = *reinterpret_cast<bf16x8*>(&w);
                }
            }
            f32x4 o[8];
#pragma unroll
            for (int et = 0; et < 8; ++et) {
                f32x4 a = f32x4{0.f, 0.f, 0.f, 0.f};
#pragma unroll
                for (int dc = 0; dc < 2; ++dc) {
                    const bf16x8 sf = *(const LAS bf16x8*)(lds + (sb0 + ((dc ^ (fr >> 3)) * 64)) + (STIMG + et * 2048));
                    a = __builtin_amdgcn_mfma_f32_16x16x32_bf16(sf, dc ? q1 : q0, a, 0, 0, 0);
                }
                a[0] *= qdec; a[1] *= qdec; a[2] *= qdec; a[3] *= qdec;
#pragma unroll
                for (int cc = 0; cc < 4; ++cc) {
                    if (cc < ncc) {
                        const bf16x8 vf = *(const LAS bf16x8*)(lds + (lb0 + ((cc ^ (fr >> 2)) * 64)) + (VTIMG + et * 4096));
                        a = __builtin_amdgcn_mfma_f32_16x16x32_bf16(vf, pf[cc], a, 0, 0, 0);
                    }
                }
                o[et] = a;
            }
#pragma unroll
            for (int dt = 0; dt < 4; ++dt) { S[dt][0] *= g128; S[dt][1] *= g128; S[dt][2] *= g128; S[dt][3] *= g128; }
#pragma unroll
            for (int cc = 0; cc < 4; ++cc) {
                const int la = lb0 + ((cc ^ (fr >> 2)) * 64);
                const bf16x8 vb = *(const LAS bf16x8*)(lds + la + wave * 4096 + VTIMG);
#pragma unroll
                for (int dt = 0; dt < 4; ++dt) {
                    const bf16x8 kt = *(const LAS bf16x8*)(lds + la + (KTIMG + dt * 4096));
                    S[dt] = __builtin_amdgcn_mfma_f32_16x16x32_bf16(kt, vb, S[dt], 0, 0, 0);
                }
            }
            __syncthreads();
            {
                const int e = wave * 16 + fr;
#pragma unroll
                for (int dt = 0; dt < 4; ++dt) {
                    u32x2 w = {pk2(S[dt][0], S[dt][1]), pk2(S[dt][2], S[dt][3])};
                    *(LAS u32x2*)(lds + STIMG + e * 128 + ((((dt * 2 + (fq >> 1)) ^ (e >> 1)) & 7) * 16) + (fq & 1) * 8) = w;
                }
            }
            float s1 = 0.f;
#pragma unroll
            for (int et = 0; et < 8; ++et) s1 += o[et][0] + o[et][1] + o[et][2] + o[et][3];
            s1 += __shfl_xor(s1, 16); s1 += __shfl_xor(s1, 32);
            const float mu = s1 * (1.f / 128.f);
            float s2 = 0.f;
#pragma unroll
            for (int et = 0; et < 8; ++et)
#pragma unroll
                for (int jj = 0; jj < 4; ++jj) { const float dlt = o[et][jj] - mu; s2 += dlt * dlt; }
            s2 += __shfl_xor(s2, 16); s2 += __shfl_xor(s2, 32);
            const float rs = rsqrtf(s2 * (1.f / 128.f) + EPS);
            u16* gp = RG + (row0 + qloc) * 512 + h * 128 + fq * 4;
#pragma unroll
            for (int et = 0; et < 8; ++et) {
                const u32x2 gv = *(const u32x2*)(gp + et * 16);
                f32x4 y;
                y[0] = siluf_(lo2f(gv[0])) * (o[et][0] - mu) * rs; y[1] = siluf_(hi2f(gv[0])) * (o[et][1] - mu) * rs;
                y[2] = siluf_(lo2f(gv[1])) * (o[et][2] - mu) * rs; y[3] = siluf_(hi2f(gv[1])) * (o[et][3] - mu) * rs;
                st4bf(gp + et * 16, y);
            }
        }
#undef RET_LOAD
        __syncthreads();
    }
}

DEVINL void ph_kmax(const Params& p, int l) {
    unsigned char* ws = WSP(p);
    const int lane = TID() & 63, gw = blockIdx.x * 8 + (TID() >> 6), GW = gridDim.x * 8;
    unsigned* kmax = (unsigned*)(ws + WS_CTL) + CW_KMAX + l * 64;
    for (int c = gw; c < 2048; c += GW) {
        const int bh = c >> 5, b = bh >> 2, h = bh & 3, s0 = (c & 31) * 128;
        float mx = 0.f;
#pragma unroll
        for (int q = 0; q < 2; ++q) {
            const u32x4* rp = (const u32x4*)((const u16*)(ws + WS_FK) + ((size_t)b * 4096 + s0 + q * 64 + lane) * 512 + h * 128);
            u32x4 v[16];
#pragma unroll
            for (int i = 0; i < 16; ++i) v[i] = rp[i];
            float ss = 0.f;
#pragma unroll
            for (int i = 0; i < 16; ++i)
#pragma unroll
                for (int e = 0; e < 4; ++e) { const float lo = lo2f(v[i][e]), hi = hi2f(v[i][e]); ss += lo * lo + hi * hi; }
            mx = fmaxf(mx, ss);
        }
        for (int o = 32; o; o >>= 1) mx = fmaxf(mx, __shfl_xor(mx, o));
        if (lane == 0) atomicMax(&kmax[bh], __float_as_uint(sqrtf(mx)));
    }
}

template <bool MLA>
DEVINL void attn_unit(const Params& p, LAS unsigned char* lds, int l, int bh, int qt) {
    unsigned char* ws = WSP(p);
    const int tid = TID(), lane = tid & 63, wave = __builtin_amdgcn_readfirstlane(tid >> 6), fr = lane & 15, fq = lane >> 4;
    const int b = bh >> 2, h = bh & 3, t0 = qt * 256, wrow0 = t0 + wave * 32;
    constexpr int DC = MLA ? 6 : 4;
    constexpr float L2E = 1.4426950408889634f;
    constexpr float C2 = (MLA ? 0.07216878364870323f : 0.08838834764831845f) * L2E;
    constexpr int BUF = 40960, VOTE_OFF = 122880;
    const size_t rowb = (size_t)b * 4096;
    const u16* Kg = (const u16*)(ws + (MLA ? WS_KN : WS_FK)) + rowb * 512 + h * 128;
    const int kld = 512;
    const unsigned char* K8g = ws + WS_KN + rowb * 512 + h * 128;
    const u16* KPg = (const u16*)(ws + WS_KPE) + rowb * 64;
    const u16* VTg = (const u16*)(ws + WS_FVT) + (size_t)bh * 128 * 4096;
    const unsigned char* VT8g = ws + WS_MVT + (size_t)bh * 128 * 4096;
    u16* Qg = MLA ? (u16*)(ws + WS_Q) + (rowb + wrow0) * 768 + h * 192 : (u16*)(ws + WS_FQ) + (rowb + wrow0) * 512 + h * 128;
    const int qld = MLA ? 768 : 512;
    u16* Og = MLA ? (u16*)(ws + WS_YC) + (rowb + wrow0) * 512 + h * 128 : Qg;
    const float* fc = (const float*)(ws + WS_FCUM) + (size_t)bh * 4096;

    bf16x8 qf[2][DC];
#pragma unroll
    for (int qs = 0; qs < 2; ++qs)
#pragma unroll
        for (int dc = 0; dc < DC; ++dc) qf[qs][dc] = *(const bf16x8*)(Qg + (size_t)(qs * 16 + fr) * qld + dc * 32 + fq * 8);
    v8i q8[2];
    if (MLA) {
#pragma unroll
        for (int qs = 0; qs < 2; ++qs) {
            unsigned w8[8];
#pragma unroll
            for (int dc = 0; dc < 4; ++dc) {
                const bf16x8 q = qf[qs][dc];
                w8[dc * 2] = pk4_f8(bf2f((u16)q[0]), bf2f((u16)q[1]), bf2f((u16)q[2]), bf2f((u16)q[3]));
                w8[dc * 2 + 1] = pk4_f8(bf2f((u16)q[4]), bf2f((u16)q[5]), bf2f((u16)q[6]), bf2f((u16)q[7]));
            }
            q8[qs] = v8i{(int)w8[0], (int)w8[1], (int)w8[2], (int)w8[3], (int)w8[4], (int)w8[5], (int)w8[6], (int)w8[7]};
        }
    }
    float Fq[2] = {0.f, 0.f}, qb[2] = {0.f, 0.f};
    if (!MLA) {
        const float kmx = __uint_as_float(((const unsigned*)(ws + WS_CTL))[CW_KMAX + l * 64 + bh]);
#pragma unroll
        for (int qs = 0; qs < 2; ++qs) {
            Fq[qs] = fc[wrow0 + qs * 16 + fr] * L2E;
            float ss = 0.f;
#pragma unroll
            for (int dc = 0; dc < 4; ++dc)
#pragma unroll
                for (int e = 0; e < 8; ++e) { const float v = bf2f((u16)qf[qs][dc][e]); ss += v * v; }
            ss += __shfl_xor(ss, 16); ss += __shfl_xor(ss, 32);
            qb[qs] = sqrtf(ss) * kmx * C2 * 1.0001f;
        }
    }
    float m[2] = {-1e30f, -1e30f}, lsum[2] = {0.f, 0.f};
    f32x4 o[2][8];
#pragma unroll
    for (int qs = 0; qs < 2; ++qs)
#pragma unroll
        for (int et = 0; et < 8; ++et) o[qs][et] = f32x4{0.f, 0.f, 0.f, 0.f};

    const int kr = tid >> 4, kc = tid & 15;
    const int swk0 = (kr & 3) | (((kr >> 3) & 3) << 2);
    const int wk0 = kr * 256 + ((kc ^ swk0) * 16);
    const int vr = tid >> 3, vc = tid & 7;
    const int wv0 = 16384 + vr * 128 + ((vc ^ ((vr >> 1) & 7)) * 16);
    const int wp = 32768 + vr * 128 + ((vc ^ (((vr >> 1) & 1) | (((vr >> 3) & 3) << 1))) * 16);
    const int rbase = (fr >> 2) * 8 + (fr & 3);
    int kb0 = rbase * 256 + ((fq ^ (fr & 3)) * 16) + ((fr >> 2) * 64);
    int kp0 = 32768 + rbase * 128 + ((((fq) ^ (fr >> 1)) & 7) * 16);
    int vb0 = 16384 + fr * 128 + ((fr >> 3) * 64) + ((fq ^ ((fr >> 1) & 3)) * 16);
    int vb8 = 16384 + fr * 64 + (((fq >> 1) ^ ((fr >> 1) & 3)) * 16) + (fq & 1) * 8;
    int k8b = rbase * 128 + ((fq ^ ((fr & 3) | (((fr >> 2) & 1) << 2))) * 16);

    bf16x8 stk0, stk1, stv0, stv1, stp;
#define LOADT(j_) do { const int s0_ = (j_) * 64; \
        if (MLA) stk0 = *(const bf16x8*)(K8g + (size_t)(s0_ + vr) * 512 + vc * 16); \
        else { stk0 = *(const bf16x8*)(Kg + (size_t)(s0_ + kr) * kld + kc * 8); stk1 = *(const bf16x8*)(Kg + (size_t)(s0_ + 32 + kr) * kld + kc * 8); } \
        if (MLA) stv0 = *(const bf16x8*)(VT8g + (size_t)(tid >> 2) * 4096 + s0_ + (tid & 3) * 16); \
        else { stv0 = *(const bf16x8*)(VTg + (size_t)vr * 4096 + s0_ + vc * 8); stv1 = *(const bf16x8*)(VTg + (size_t)(vr + 64) * 4096 + s0_ + vc * 8); } \
        if (MLA) stp = *(const bf16x8*)(KPg + (size_t)(s0_ + vr) * 64 + vc * 8); } while (0)
#define WRITET(bf_) do { LAS unsigned char* d_ = lds + (bf_) * BUF; int tl_ = tid; asm volatile("" : "+v"(tl_));     \
        const int kr_ = tl_ >> 4, kc_ = tl_ & 15, vr_ = tl_ >> 3, vc_ = tl_ & 7; \
        const int wk_ = kr_ * 256 + ((kc_ ^ ((kr_ & 3) | (((kr_ >> 3) & 3) << 2))) * 16), wv_ = 16384 + vr_ * 128 + ((vc_ ^ ((vr_ >> 1) & 7)) * 16); \
        if (MLA) *(LAS bf16x8*)(d_ + vr_ * 128 + ((vc_ ^ ((vr_ & 3) | (((vr_ >> 3) & 1) << 2))) * 16)) = stk0; \
        else { *(LAS bf16x8*)(d_ + wk_) = stk0; *(LAS bf16x8*)(d_ + wk_ + 8192) = stk1; } \
        if (MLA) *(LAS bf16x8*)(d_ + 16384 + (tl_ >> 2) * 64 + (((tl_ & 3) ^ ((tl_ >> 3) & 3)) * 16)) = stv0; \
        else { *(LAS bf16x8*)(d_ + wv_) = stv0; *(LAS bf16x8*)(d_ + wv_ + 8192) = stv1; } \
        if (MLA) *(LAS bf16x8*)(d_ + 32768 + vr_ * 128 + ((vc_ ^ (((vr_ >> 1) & 1) | (((vr_ >> 3) & 3) << 1))) * 16)) = stp; } while (0)

    const int jmax = qt * 4 + 3;
    LOADT(jmax); WRITET(0);
    __syncthreads();
    bf16x8 pfp[2][2]; long pfp8[2][2]; bool pact = false;
    int cur = 0, prv = 2, nxt = 1;
    for (int j = jmax, it = 0;; --j, ++it) {
        LAS unsigned char* bufp = lds + cur * BUF;
        LAS unsigned char* bufq = lds + prv * BUF;
        if (j > 0) LOADT(j - 1);
        const bool act = (64 * j <= wrow0 + 31);
        asm volatile("" : "+v"(kb0), "+v"(kp0), "+v"(vb0), "+v"(k8b), "+v"(vb8));
#define kbL kb0
#define kpL kp0
#define vbL vb0
        f32x4 sa[2][4];
        if (act) {
#pragma unroll
            for (int qs = 0; qs < 2; ++qs)
#pragma unroll
                for (int kt = 0; kt < 4; ++kt) sa[qs][kt] = f32x4{0.f, 0.f, 0.f, 0.f};
            __builtin_amdgcn_s_setprio(1);
            if constexpr (MLA) {
#pragma unroll
                for (int kt = 0; kt < 4; ++kt)
#pragma unroll
                    for (int dcp = 0; dcp < 2; ++dcp) {
                        const bf16x8 kf = *(LAS bf16x8*)(bufp + (kpL ^ (dcp << 6)) + (kt >> 1) * 4096 + (kt & 1) * 512);
                        sa[0][kt] = __builtin_amdgcn_mfma_f32_16x16x32_bf16(kf, qf[0][DC - 2 + dcp], sa[0][kt], 0, 0, 0);
                        sa[1][kt] = __builtin_amdgcn_mfma_f32_16x16x32_bf16(kf, qf[1][DC - 2 + dcp], sa[1][kt], 0, 0, 0);
                    }
                v8i k8[4];
#pragma unroll
                for (int kt = 0; kt < 4; ++kt) {
                    const v4i lo_ = *(const LAS v4i*)(bufp + k8b + (kt >> 1) * 4096 + (kt & 1) * 512), hi_ = *(const LAS v4i*)(bufp + (k8b ^ 64) + (kt >> 1) * 4096 + (kt & 1) * 512);
                    k8[kt] = __builtin_shufflevector(lo_, hi_, 0, 1, 2, 3, 4, 5, 6, 7);
                }
                asm volatile("s_nop 15" ::: "memory");
#pragma unroll
                for (int kt = 0; kt < 4; ++kt) {
                    asm volatile("v_mfma_f32_16x16x128_f8f6f4 %0, %1, %2, %0" : "+v"(sa[0][kt]) : "v"(k8[kt]), "v"(q8[0]));
                    asm volatile("v_mfma_f32_16x16x128_f8f6f4 %0, %1, %2, %0" : "+v"(sa[1][kt]) : "v"(k8[kt]), "v"(q8[1]));
                }
                asm volatile("s_nop 15\n\ts_nop 15" ::: "memory");
            } else {
#pragma unroll
            for (int kt = 0; kt < 4; ++kt) {
#pragma unroll
                for (int dc = 0; dc < 4; ++dc) {
                    const bf16x8 kf = *(LAS bf16x8*)(bufp + (kbL ^ (dc << 6)) + (kt >> 1) * 8192 + (kt & 1) * 1024);
                    sa[0][kt] = __builtin_amdgcn_mfma_f32_16x16x32_bf16(kf, qf[0][dc], sa[0][kt], 0, 0, 0);
                    sa[1][kt] = __builtin_amdgcn_mfma_f32_16x16x32_bf16(kf, qf[1][dc], sa[1][kt], 0, 0, 0);
                }
            }
            }
            __builtin_amdgcn_s_setprio(0);
        }
        if (pact) {
            __builtin_amdgcn_s_setprio(1);
#pragma unroll
            for (int c32 = 0; c32 < 2; ++c32)
#pragma unroll
                for (int et = 0; et < 8; ++et) {
                    if constexpr (MLA) {
                        const long vf = *(LAS long*)(bufq + (vb8 ^ (c32 << 5)) + et * 1024);
                        o[0][et] = __builtin_amdgcn_mfma_f32_16x16x32_fp8_fp8(vf, pfp8[0][c32], o[0][et], 0, 0, 0);
                        o[1][et] = __builtin_amdgcn_mfma_f32_16x16x32_fp8_fp8(vf, pfp8[1][c32], o[1][et], 0, 0, 0);
                    } else {
                    const bf16x8 vf = *(LAS bf16x8*)(bufq + (vbL ^ (c32 << 6)) + et * 2048);
                    o[0][et] = __builtin_amdgcn_mfma_f32_16x16x32_bf16(vf, pfp[0][c32], o[0][et], 0, 0, 0);
                    o[1][et] = __builtin_amdgcn_mfma_f32_16x16x32_bf16(vf, pfp[1][c32], o[1][et], 0, 0, 0);
                    }
                }
            __builtin_amdgcn_s_setprio(0);
        }
        if (act) {
            float fkl[2][8];
            if (!MLA) {
#pragma unroll
                for (int c32 = 0; c32 < 2; ++c32) {
                    const float4 a = *(const float4*)(fc + 64 * j + c32 * 32 + fq * 8), c = *(const float4*)(fc + 64 * j + c32 * 32 + fq * 8 + 4);
                    fkl[c32][0] = a.x * L2E; fkl[c32][1] = a.y * L2E; fkl[c32][2] = a.z * L2E; fkl[c32][3] = a.w * L2E;
                    fkl[c32][4] = c.x * L2E; fkl[c32][5] = c.y * L2E; fkl[c32][6] = c.z * L2E; fkl[c32][7] = c.w * L2E;
                }
            }
            const bool needmask = (64 * j + 63 > wrow0);
            bf16x8 pf[2][2];
#pragma unroll
            for (int qs = 0; qs < 2; ++qs) {
                const int row = wrow0 + qs * 16 + fr;
                if (!MLA) {
#pragma unroll
                    for (int kt = 0; kt < 4; ++kt)
#pragma unroll
                        for (int jj = 0; jj < 4; ++jj) sa[qs][kt][jj] = fmaf(sa[qs][kt][jj], C2, Fq[qs] - fkl[kt >> 1][(kt & 1) * 4 + jj]);
                }
                if (needmask) {
#pragma unroll
                    for (int kt = 0; kt < 4; ++kt)
#pragma unroll
                        for (int jj = 0; jj < 4; ++jj) { const int key = 64 * j + (kt >> 1) * 32 + fq * 8 + (kt & 1) * 4 + jj; if (key > row) sa[qs][kt][jj] = -__builtin_inff(); }
                }
                float mx = sa[qs][0][0];
#pragma unroll
                for (int kt = 0; kt < 4; ++kt)
#pragma unroll
                    for (int jj = 0; jj < 4; ++jj) mx = fmaxf(mx, sa[qs][kt][jj]);
                mx = fmaxf(mx, __shfl_xor(mx, 16)); mx = fmaxf(mx, __shfl_xor(mx, 32));
                if (MLA) mx *= C2;
                const float mn = fmaxf(m[qs], mx);
                const float al = __builtin_amdgcn_exp2f(m[qs] - mn);
                m[qs] = mn;
                if (__any(al != 1.f)) {
#pragma unroll
                    for (int et = 0; et < 8; ++et) { o[qs][et][0] *= al; o[qs][et][1] *= al; o[qs][et][2] *= al; o[qs][et][3] *= al; }
                }
                float rs = 0.f;
#pragma unroll
                for (int kt = 0; kt < 4; ++kt)
#pragma unroll
                    for (int jj = 0; jj < 4; ++jj) {
                        const float pv = MLA ? __builtin_amdgcn_exp2f(fmaf(sa[qs][kt][jj], C2, -mn)) : __builtin_amdgcn_exp2f(sa[qs][kt][jj] - mn);
                        rs += pv; sa[qs][kt][jj] = pv;
                    }
                lsum[qs] = lsum[qs] * al + rs;
#pragma unroll
                for (int c32 = 0; c32 < 2; ++c32) {
                    if constexpr (MLA) {
                        const unsigned lo_ = pk4_f8(sa[qs][2 * c32][0], sa[qs][2 * c32][1], sa[qs][2 * c32][2], sa[qs][2 * c32][3]);
                        const unsigned hi_ = pk4_f8(sa[qs][2 * c32 + 1][0], sa[qs][2 * c32 + 1][1], sa[qs][2 * c32 + 1][2], sa[qs][2 * c32 + 1][3]);
                        pfp8[qs][c32] = (long)(((unsigned long long)hi_ << 32) | lo_);
                    } else {
                    u32x4 w = {pk2(sa[qs][2 * c32][0], sa[qs][2 * c32][1]), pk2(sa[qs][2 * c32][2], sa[qs][2 * c32][3]),
                               pk2(sa[qs][2 * c32 + 1][0], sa[qs][2 * c32 + 1][1]), pk2(sa[qs][2 * c32 + 1][2], sa[qs][2 * c32 + 1][3])};
                    pf[qs][c32] = *reinterpret_cast<bf16x8*>(&w);
                    }
                }
            }
            if (!MLA) { pfp[0][0] = pf[0][0]; pfp[0][1] = pf[0][1]; pfp[1][0] = pf[1][0]; pfp[1][1] = pf[1][1]; }
        }
        pact = act;
        if (j > 0) WRITET(nxt);
        bool stop = (j == 0);
        if (!MLA && !stop) {
            const float fk1 = fc[64 * j - 1] * L2E;
            const bool c0 = (qb[0] + Fq[0] - fk1 < m[0] - 151.5f), c1 = (qb[1] + Fq[1] - fk1 < m[1] - 151.5f);
            const bool wv = __all(c0 && c1);
            if (lane == 0) ((LAS unsigned*)(lds + VOTE_OFF))[(it & 1) * 8 + wave] = wv ? 1u : 0u;
        }
        __syncthreads();
        if (!MLA && !stop) {
            const u32x4 v0 = *(LAS u32x4*)(lds + VOTE_OFF + (it & 1) * 32), v1 = *(LAS u32x4*)(lds + VOTE_OFF + (it & 1) * 32 + 16);
            stop = (v0[0] & v0[1] & v0[2] & v0[3] & v1[0] & v1[1] & v1[2] & v1[3]) != 0u;
        }
        if (stop) break;
        prv = cur; cur = nxt; nxt = (nxt == 2) ? 0 : nxt + 1;
    }
    if (pact) {
        LAS unsigned char* bufq = lds + cur * BUF;
#pragma unroll
        for (int c32 = 0; c32 < 2; ++c32)
#pragma unroll
            for (int et = 0; et < 8; ++et) {
                if constexpr (MLA) {
                    const long vf = *(LAS long*)(bufq + (vb8 ^ (c32 << 5)) + et * 1024);
                    o[0][et] = __builtin_amdgcn_mfma_f32_16x16x32_fp8_fp8(vf, pfp8[0][c32], o[0][et], 0, 0, 0);
                    o[1][et] = __builtin_amdgcn_mfma_f32_16x16x32_fp8_fp8(vf, pfp8[1][c32], o[1][et], 0, 0, 0);
                } else {
                const bf16x8 vf = *(LAS bf16x8*)(bufq + (vb0 ^ (c32 << 6)) + et * 2048);
                o[0][et] = __builtin_amdgcn_mfma_f32_16x16x32_bf16(vf, pfp[0][c32], o[0][et], 0, 0, 0);
                o[1][et] = __builtin_amdgcn_mfma_f32_16x16x32_bf16(vf, pfp[1][c32], o[1][et], 0, 0, 0);
                }
            }
    }
#undef LOADT
#undef WRITET
#undef kbL
#undef kpL
#undef vbL
#pragma unroll
    for (int qs = 0; qs < 2; ++qs) {
        float lt = lsum[qs];
        lt += __shfl_xor(lt, 16); lt += __shfl_xor(lt, 32);
        const float inv = 1.f / lt;
        u16* orow = Og + (size_t)(qs * 16 + fr) * 512;
#pragma unroll
        for (int et = 0; et < 8; ++et) {
            f32x4 v = o[qs][et]; v[0] *= inv; v[1] *= inv; v[2] *= inv; v[3] *= inv;
            st4bf(orow + et * 16 + fq * 4, v);
        }
    }
}
constexpr int CW_QUEUE = 6144;
DEVINL void ph_mixers(const Params& p, int l, LAS unsigned char* lds) {
    unsigned* q = (unsigned*)(WSP(p) + WS_CTL) + CW_QUEUE + l * 64;
    LAS unsigned* slot = (LAS unsigned*)(lds + 123008);
    for (;;) {
        __syncthreads();
        if (TID() == 0) *slot = __hip_atomic_fetch_add(q, 1u, __ATOMIC_RELAXED, __HIP_MEMORY_SCOPE_AGENT);
        __syncthreads();
        const int it = (int)__builtin_amdgcn_readfirstlane(*slot);
        if (it >= 64 + 2048) break;
        if (it < 64) retention_unit(p, lds, it);
        else if (it < 64 + 1024) { const int i = it - 64; attn_unit<true>(p, lds, l, i & 63, 15 - (i >> 6)); }
        else { const int i = it - 1088; attn_unit<false>(p, lds, l, i & 63, 15 - (i >> 6)); }
    }
}

struct EpiQ { unsigned char* ws;
    DEVINL bool keep(const GUnit&) const { return false; }
    DEVINL void operator()(const GAcc& acc, const GUnit& u, int wr, int wc, int fr, int fq) const {
        u16* dst = (u16*)(ws + WS_Q);
        const float2* tab = (const float2*)(ws + WS_ROPE);
#pragma unroll
        for (int bj = 0; bj < 2; ++bj) {
            const int cb = G_RUN(u, bj), hh = cb / 192, w = cb - hh * 192;
            if (w >= 128) {
                const int g = (w - 128) >> 5, i0 = 16 * g + 4 * fq;
#pragma unroll
                for (int ai = 0; ai < 2; ++ai)
#pragma unroll
                    for (int m = 0; m < 4; ++m) {
                        int row = G_ROW(u, ai, m); asm volatile("" : "+v"(row));
                        const float4 t0 = *(const float4*)(tab + (size_t)row * 32 + i0), t1 = *(const float4*)(tab + (size_t)row * 32 + i0 + 2);
                        const f32x4 x1 = acc[ai][bj][m][0], x2 = acc[ai][bj][m][1];
                        f32x4 y1, y2;
                        y1[0] = x1[0] * t0.x - x2[0] * t0.y; y2[0] = x2[0] * t0.x + x1[0] * t0.y;
                        y1[1] = x1[1] * t0.z - x2[1] * t0.w; y2[1] = x2[1] * t0.z + x1[1] * t0.w;
                        y1[2] = x1[2] * t1.x - x2[2] * t1.y; y2[2] = x2[2] * t1.x + x1[2] * t1.y;
                        y1[3] = x1[3] * t1.z - x2[3] * t1.w; y2[3] = x2[3] * t1.z + x1[3] * t1.w;
                        u16* rp = dst + (size_t)row * 768 + hh * 192 + 128 + i0;
                        st4bf(rp, y1); st4bf(rp + 32, y2);
                        asm volatile("" ::: "memory");
                    }
            } else {
#pragma unroll
                for (int ai = 0; ai < 2; ++ai)
#pragma unroll
                    for (int m = 0; m < 4; ++m) {
                        st8bf(dst + (size_t)G_ROW(u, ai, m) * 768 + cb + fq * 8, acc[ai][bj][m][0], acc[ai][bj][m][1]);
                    }
            }
        }
    }
};
DEVINL void ph_gemm_mla_up(const Params& p, LAS unsigned char* lds) {
    unsigned char* ws = WSP(p);
    { DenseSched S{(const char*)(ws + WS_MQ), (const char*)(ws + WS_WQ), 256, 256, 256, 3, 0ull};
      gemm_phase_t<false, false, false, false, false>(lds, S, EpiQ{ws}, 256, 256, 256); }
    { DenseSched S{(const char*)(ws + WS_MKV), (const char*)(ws + WS_WKV), 128, 128, 256, 2, 0ull};
      gemm_phase_t<false, false, false, false, false>(lds, S, EpiStore{ws + WS_KN}, 128, 128, 128); }
    { DenseSched S{(const char*)(ws + WS_MKV), (const char*)(ws + WS_WKV), 128, 128, 256, 2, 0x32ull};
      gemm_phase_t<true, false, false, false, false>(lds, S, EpiVT8{ws + WS_MVT}, 128, 128, 128); }
}
struct EpiGate { unsigned char* ws; const float* bias;
    DEVINL bool keep(const GUnit&) const { return false; }
    DEVINL void operator()(const GAcc& acc, const GUnit& u, int wr, int wc, int fr, int fq) const {
        const int i = u.pn >> 2;
        unsigned char* dst = ws + (i == 0 ? WS_G0 : (i == 1 ? WS_G1 : WS_G2));
        const int cg = u.pn * 256 + wc * 64 + fq * 16, cl = cg & 1023;
        float bz[16];
#pragma unroll
        for (int q = 0; q < 4; ++q) { const float4 b4 = *(const float4*)(bias + cg + q * 4); bz[q * 4] = b4.x; bz[q * 4 + 1] = b4.y; bz[q * 4 + 2] = b4.z; bz[q * 4 + 3] = b4.w; }
        constexpr float R = 1.f / W8_SCALE;
#pragma unroll
        for (int ai = 0; ai < 2; ++ai)
#pragma unroll
            for (int m = 0; m < 4; ++m) {
                unsigned w[4];
#pragma unroll
                for (int bj = 0; bj < 2; ++bj)
#pragma unroll
                    for (int n = 0; n < 2; ++n) {
                        const f32x4 v = acc[ai][bj][m][n];
                        unsigned pk = 0u;
#pragma unroll
                        for (int j = 0; j < 4; ++j) pk = __builtin_amdgcn_cvt_pk_u8_f32(fmaxf(rintf(sigmoidf_(fmaf(v[j], R, bz[bj * 8 + n * 4 + j])) * 255.f), 1.f), j, pk);
                        w[bj * 2 + n] = pk;
                    }
                const u32x4 o = {w[0], w[1], w[2], w[3]};
                *(u32x4*)(dst + (size_t)G_ROW(u, ai, m) * 1024 + cl) = o;
            }
    }
};
DEVINL void ph_gates(const Params& p, int l, LAS unsigned char* lds) {
    unsigned char* ws = WSP(p);
    DenseSched S{(const char*)H8P(p), (const char*)(ws + WS_GATE), 512, 512, 256, 12, 0ull};
    gemm_phase_t<false, false, G_SP2, G_ALIGN, true>(lds, S, EpiGate{ws, p.in[I_GATEB] + (size_t)l * 3072}, 512, 512, 512);
}
struct EpiBranch { unsigned char* ws;
    DEVINL bool keep(const GUnit& u) const { return u.sub != 2; }
    DEVINL void operator()(GAcc& acc, const GUnit& u, int wr, int wc, int fr, int fq) const {
        const int i = u.sub;
        const unsigned char* Gc = ws + (i == 0 ? WS_G0 : (i == 1 ? WS_G1 : WS_G2));
        const unsigned char* Gn = ws + (i == 0 ? WS_G1 : WS_G2);
        u16* M = (u16*)(ws + WS_MERGED);
#pragma unroll
        for (int ai = 0; ai < 2; ++ai)
#pragma unroll
            for (int m = 0; m < 4; ++m) {
                const size_t off = (size_t)G_ROW(u, ai, m) * 1024 + u.pn * 256 + wc * 64 + fq * 16;
                const u32x4 g = *(const u32x4*)(Gc + off);
                u32x4 h = g;
                if (i != 2) h = *(const u32x4*)(Gn + off);
#pragma unroll
                for (int bj = 0; bj < 2; ++bj)
#pragma unroll
                    for (int n = 0; n < 2; ++n) {
                        const unsigned gw = g[bj * 2 + n], hw = h[bj * 2 + n];
                        f32x4 v = acc[ai][bj][m][n];
#pragma unroll
                        for (int j = 0; j < 4; ++j) {
                            const float gq = (float)((gw >> (8 * j)) & 255u);
                            v[j] *= (i != 2) ? gq * __builtin_amdgcn_rcpf((float)((hw >> (8 * j)) & 255u)) : gq * (1.f / 255.f);
                        }
                        acc[ai][bj][m][n] = v;
                    }
                if (i == 2) { st8bf(M + off, acc[ai][0][m][0], acc[ai][0][m][1]); st8bf(M + off + 8, acc[ai][1][m][0], acc[ai][1][m][1]); }
            }
    }
};
DEVINL void ph_branch(const Params& p, LAS unsigned char* lds) {
    unsigned char* ws = WSP(p);
    BranchSched S{(const char*)(ws + WS_RG), (const char*)(ws + WS_FQ), (const char*)(ws + WS_YC), (const char*)(ws + WS_BR)};
    gemm_phase(lds, S, EpiBranch{ws}, 512, 512, 512);
}
template <bool XBF>
struct EpiOut { const void* xin; u16* out; const float* gt;
    DEVINL bool keep(const GUnit&) const { return false; }
    DEVINL void operator()(const GAcc& acc, const GUnit& u, int wr, int wc, int fr, int fq) const {
        const int b = u.pm >> 4, c = u.pn * 256 + wc * 64 + fq * 16;
        float g[16];
#pragma unroll
        for (int q = 0; q < 4; ++q) { const float4 g4 = *(const float4*)(gt + b * 6144 + c + q * 4); g[q * 4] = g4.x; g[q * 4 + 1] = g4.y; g[q * 4 + 2] = g4.z; g[q * 4 + 3] = g4.w; }
#pragma unroll
        for (int ai = 0; ai < 2; ++ai)
#pragma unroll
            for (int m = 0; m < 4; ++m) {
                const size_t off = (size_t)G_ROW(u, ai, m) * 1024 + c;
                float xa[16];
                if constexpr (XBF) {
#pragma unroll
                    for (int q = 0; q < 2; ++q) { const u32x4 v = *(const u32x4*)((const u16*)xin + off + q * 8);
                        xa[q * 8 + 0] = lo2f(v[0]); xa[q * 8 + 1] = hi2f(v[0]); xa[q * 8 + 2] = lo2f(v[1]); xa[q * 8 + 3] = hi2f(v[1]); xa[q * 8 + 4] = lo2f(v[2]); xa[q * 8 + 5] = hi2f(v[2]); xa[q * 8 + 6] = lo2f(v[3]); xa[q * 8 + 7] = hi2f(v[3]); }
                } else {
#pragma unroll
                    for (int q = 0; q < 4; ++q) { const float4 v = *(const float4*)((const float*)xin + off + q * 4); xa[q * 4] = v.x; xa[q * 4 + 1] = v.y; xa[q * 4 + 2] = v.z; xa[q * 4 + 3] = v.w; }
                }
#pragma unroll
                for (int bj = 0; bj < 2; ++bj) {
                    const f32x4 a0 = acc[ai][bj][m][0], a1 = acc[ai][bj][m][1];
                    const float* xb = xa + bj * 8; const float* gb = g + bj * 8;
                    const u32x4 o = {pk2(xb[0] + gb[0] * a0[0], xb[1] + gb[1] * a0[1]), pk2(xb[2] + gb[2] * a0[2], xb[3] + gb[3] * a0[3]),
                                     pk2(xb[4] + gb[4] * a1[0], xb[5] + gb[5] * a1[1]), pk2(xb[6] + gb[6] * a1[2], xb[7] + gb[7] * a1[3])};
                    *(u32x4*)(out + off + bj * 8) = o;
                }
            }
    }
};
DEVINL void ph_gemm_out(const Params& p, int l, LAS unsigned char* lds) {
    unsigned char* ws = WSP(p);
    DenseSched S{(const char*)(ws + WS_MERGED), (const char*)(ws + WS_OUTW), 1024, 1024, 256, 4, 0ull};
    const float* gt = (const float*)(ws + WS_MOD) + (size_t)l * 16 * 6144 + 2 * 1024;
    if (l == 0) gemm_phase(lds, S, EpiOut<false>{(const void*)p.in[I_X], (u16*)(ws + WS_XM), gt}, 1024, 1024, 1024);
    else gemm_phase(lds, S, EpiOut<true>{(const void*)p.out, (u16*)(ws + WS_XM), gt}, 1024, 1024, 1024);
}

DEVINL void moe_offsets(const Params& p, int l, LAS int* poff  ) {
    if (TID() == 0) {
        const unsigned* cnt = (const unsigned*)(WSP(p) + WS_CTL) + CW_CNT + l * 32;
        int a = 0;
        for (int e = 0; e < 32; ++e) { poff[e] = a; a += (int)((cnt[e] + 255u) & ~255u); }
        poff[32] = a;
    }
    __syncthreads();
}
DEVINL void ph_scatter(const Params& p, int l, LAS unsigned char* lds) {
    unsigned char* ws = WSP(p);
    LAS int* poff = (LAS int*)lds;
    moe_offsets(p, l, poff);
    int* tokl = (int*)(ws + WS_TOKL); float* wl = (float*)(ws + WS_WL);
    const int4* rt = (const int4*)(ws + WS_ROUTE);
    for (int i = blockIdx.x * NTHR + TID(); i < T_ * 2; i += gridDim.x * NTHR) {
        const int4 r = rt[i];
        const int d = poff[r.x] + r.y;
        tokl[d] = i >> 1; wl[d] = __int_as_float(r.z);
    }
    const unsigned* cnt = (const unsigned*)(ws + WS_CTL) + CW_CNT + l * 32;
    for (int i = blockIdx.x * NTHR + TID(); i < 32 * 256; i += gridDim.x * NTHR) {
        const int e = i >> 8, r = poff[e] + (int)cnt[e] + (i & 255);
        if (r < poff[e + 1]) { tokl[r] = 0; wl[r] = 0.f; }
    }
    __syncthreads();
}
struct EpiUp { unsigned char* hid;
    DEVINL bool keep(const GUnit&) const { return false; }
    DEVINL void operator()(const GAcc& acc, const GUnit& u, int wr, int wc, int fr, int fq) const {
        constexpr float R = 1.f / W8_SCALE;
#pragma unroll
        for (int ai = 0; ai < 2; ++ai)
#pragma unroll
            for (int m = 0; m < 4; ++m) {
                float v[8];
#pragma unroll
                for (int bj = 0; bj < 2; ++bj) {
                    const f32x4 a = acc[ai][bj][m][0], c = acc[ai][bj][m][1];
#pragma unroll
                    for (int j = 0; j < 4; ++j) v[bj * 4 + j] = siluf_(a[j] * R) * (c[j] * R);
                }
                u32x2 o = {pk4_f8(v[0], v[1], v[2], v[3]), pk4_f8(v[4], v[5], v[6], v[7])};
                *(u32x2*)(hid + (size_t)G_ROW(u, ai, m) * 512 + u.pn * 128 + wc * 32 + fq * 8) = o;
            }
    }
};
DEVINL void ph_moe_up(const Params& p, int l, LAS unsigned char* lds) {
    unsigned char* ws = WSP(p);
    LAS int* poff = (LAS int*)(lds + LDS_POFF);
    moe_offsets(p, l, poff);
    MoeGatherSched S{(const char*)(ws + WS_H), (const char*)(ws + WS_W13), 512, (size_t)1024 * 1024, poff, (const int*)(ws + WS_TOKL)};
    gemm_phase_t<false, true, G_SP2, G_ALIGN, true>(lds, S, EpiUp{ws + WS_HID}, 512, 512, 512);
}
struct EpiDown { u16* y; const float* wl;
    DEVINL bool keep(const GUnit&) const { return false; }
    DEVINL void operator()(const GAcc& acc, const GUnit& u, int wr, int wc, int fr, int fq) const {
#pragma unroll
        for (int ai = 0; ai < 2; ++ai)
#pragma unroll
            for (int m = 0; m < 4; ++m) {
                const int row = G_ROW(u, ai, m);
                const float w = wl[row] * (1.f / W8_SCALE);
                u16* rp = y + (size_t)row * 1024 + u.pn * 256 + wc * 64 + fq * 16;
#pragma unroll
                for (int bj = 0; bj < 2; ++bj) {
                    f32x4 v0 = acc[ai][bj][m][0], v1 = acc[ai][bj][m][1];
                    v0[0] *= w; v0[1] *= w; v0[2] *= w; v0[3] *= w; v1[0] *= w; v1[1] *= w; v1[2] *= w; v1[3] *= w;
                    st8bf(rp + bj * 8, v0, v1);
                }
            }
    }
};
DEVINL void ph_moe_down(const Params& p, int l, LAS unsigned char* lds) {
    unsigned char* ws = WSP(p);
    LAS int* poff = (LAS int*)(lds + LDS_POFF);
    moe_offsets(p, l, poff);
    MoeSched S{(const char*)(ws + WS_HID), (const char*)(ws + WS_W2), 256, 256, (size_t)1024 * 512, poff};
    gemm_phase_t<false, false, G_SP2, G_ALIGN, true>(lds, S, EpiDown{(u16*)(ws + WS_YEXP), (const float*)(ws + WS_WL)}, 256, 256, 256);
}

template <bool LAST>
DEVINL void ph_combine(const Params& p, int l, LAS unsigned char* lds) {
    unsigned char* ws = WSP(p);
    LAS int* poff = (LAS int*)lds;
    moe_offsets(p, l, poff);
    const int lane = TID() & 63, gw = blockIdx.x * 8 + (TID() >> 6), GW = gridDim.x * 8;
    const float* mod = (const float*)(ws + WS_MOD) + (size_t)l * 16 * 6144;
    const float* modn = (const float*)(ws + WS_MOD) + (size_t)(l + 1) * 16 * 6144;
    const int4* rt = (const int4*)(ws + WS_ROUTE);
    const u16* Y = (const u16*)(ws + WS_YEXP);
    u16* H = (u16*)(ws + WS_H);
    const u16* XM = (const u16*)(ws + WS_XM);
    unsigned char* H8 = H8P(p);
    u16* X1 = (u16*)p.out;
    for (int t0 = gw * 32; t0 < T_; t0 += GW * 32) {
        const int b = t0 >> 12;
        float gt[16], gs[16], sv[16];
#pragma unroll
        for (int i = 0; i < 4; ++i) { const float4 g4 = *(const float4*)(mod + b * 6144 + 5 * 1024 + i * 256 + lane * 4); gt[i * 4] = g4.x; gt[i * 4 + 1] = g4.y; gt[i * 4 + 2] = g4.z; gt[i * 4 + 3] = g4.w; }
        if (!LAST) norm_consts(p.in[I_N1G] + (size_t)(l + 1) * 1024, modn, modn + 1024, b, lane, gs, sv);
        else {
#pragma unroll
            for (int i = 0; i < 4; ++i) { const float4 g4 = *(const float4*)(p.in[I_FING] + i * 256 + lane * 4); gs[i * 4] = g4.x; gs[i * 4 + 1] = g4.y; gs[i * 4 + 2] = g4.z; gs[i * 4 + 3] = g4.w; }
        }
#pragma unroll 1
        for (int r = 0; r < 32; r += 2) {
            float xv[2][16];
#pragma unroll
            for (int q = 0; q < 2; ++q) {
                const int t = t0 + r + q;
                const int4 r0 = rt[t * 2], r1 = rt[t * 2 + 1];
                const u16* y0 = Y + (size_t)(poff[r0.x] + r0.y) * 1024; const u16* y1 = Y + (size_t)(poff[r1.x] + r1.y) * 1024;
#pragma unroll
                for (int i = 0; i < 4; ++i) {
                    const int c0 = i * 256 + lane * 4;
                    const u32x2 v = *(const u32x2*)(XM + (size_t)t * 1024 + c0);
                    const u32x2 a = *(const u32x2*)(y0 + c0), c = *(const u32x2*)(y1 + c0);
                    xv[q][i * 4 + 0] = lo2f(v[0]) + gt[i * 4 + 0] * (lo2f(a[0]) + lo2f(c[0]));
                    xv[q][i * 4 + 1] = hi2f(v[0]) + gt[i * 4 + 1] * (hi2f(a[0]) + hi2f(c[0]));
                    xv[q][i * 4 + 2] = lo2f(v[1]) + gt[i * 4 + 2] * (lo2f(a[1]) + lo2f(c[1]));
                    xv[q][i * 4 + 3] = hi2f(v[1]) + gt[i * 4 + 3] * (hi2f(a[1]) + hi2f(c[1]));
                }
            }
#pragma unroll
            for (int q = 0; q < 2; ++q) {
                const int t = t0 + r + q;
                if (!LAST) {
#pragma unroll
                    for (int i = 0; i < 4; ++i) { const u32x2 o = {pk2(xv[q][i * 4], xv[q][i * 4 + 1]), pk2(xv[q][i * 4 + 2], xv[q][i * 4 + 3])}; *(u32x2*)(X1 + (size_t)t * 1024 + i * 256 + lane * 4) = o; }
                    norm_store_row(H + (size_t)t * 1024, H8 + (size_t)t * 1024, lane, xv[q], gs, sv);
                } else {
                    float ss = 0.f;
#pragma unroll
                    for (int i = 0; i < 16; ++i) ss += xv[q][i] * xv[q][i];
                    ss = wsum(ss);
                    const float rstd = rsqrtf(ss * (1.f / 1024.f) + EPS);
#pragma unroll
                    for (int i = 0; i < 4; ++i)
                        *(float4*)(p.out + (size_t)t * 1024 + i * 256 + lane * 4) = make_float4(xv[q][i * 4] * rstd * gs[i * 4], xv[q][i * 4 + 1] * rstd * gs[i * 4 + 1], xv[q][i * 4 + 2] * rstd * gs[i * 4 + 2], xv[q][i * 4 + 3] * rstd * gs[i * 4 + 3]);
                }
            }
        }
    }
}

constexpr int NPL = 12, NPHASES = 2 + 2 * NPL;

__global__ void __launch_bounds__(NTHR, 2) mega(Params p) {
    extern __shared__ __attribute__((aligned(16))) unsigned char lds_raw[];
    LAS unsigned char* lds = (LAS unsigned char*)lds_raw;
    LAS unsigned* xbw = (LAS unsigned*)(lds + LDS_BYTES - 16);
    if (threadIdx.x == 0) { xbw[0] = 0u; xbw[1] = 0u; xbw[2] = 0u; xbw[3] = 0u; }
    __syncthreads();
    XcdBarrier bar; bar.bar = (unsigned*)(p.ws + WS_CTL); bar.x = 0; bar.st = (volatile LAS unsigned*)xbw;
    const bool multi = (p.ph_hi - p.ph_lo) > 1;
    if (multi) bar = xcd_barrier_post((unsigned*)(p.ws + WS_CTL), (volatile LAS unsigned*)xbw);
    const int lo = p.ph_lo, hi = p.ph_hi;
#ifdef ONLY
#define PHEN(k) (((k) < 2 ? (k) : 2 + ((k) - 2) % NPL) == ONLY)
#elif defined(SKIP)
#define PHEN(k) (((k) < 2 ? (k) : 2 + ((k) - 2) % NPL) != SKIP)
#else
#define PHEN(k) true
#endif
#define IN(k) (PHEN(k) && lo <= (k) && (k) < hi)
#define SEAM(k) do { if (IN(k) && IN((k) + 1)) xcd_barrier(bar); } while (0)
    unsigned char* ws = p.ws;

    if (IN(0)) { ph_mod(p, lds); ph_rope_table(p); ph_conv_layer(p, 0, lds); }
    SEAM(0);
    if (IN(1)) { ph_rtab(p); ph_norm(p, 0, p.in[I_X], p.in[I_N1G], 0, 1024); }
    SEAM(1);
#pragma unroll
    for (int l = 0; l < 2; ++l) {
        const int pb = 2 + l * NPL;
        if (IN(pb + 0)) ph_gemm_in(p, lds);
        SEAM(pb + 0);
        if (IN(pb + 1)) {
            rmsnorm_inplace<256>((u16*)(ws + WS_MQ), p.in[I_MQG] + l * 256);
            rmsnorm_inplace<128>((u16*)(ws + WS_MKV), p.in[I_MKVG] + l * 128);
            ph_fcum(p, l, lds);
            ph_kmax(p, l);
        }
        SEAM(pb + 1);
        if (IN(pb + 2)) ph_gemm_mla_up(p, lds);
        SEAM(pb + 2);
        if (IN(pb + 3)) ph_mixers(p, l, lds);
        SEAM(pb + 3);
        if (IN(pb + 4)) ph_gates(p, l, lds);
        SEAM(pb + 4);
        if (IN(pb + 5)) ph_branch(p, lds);
        SEAM(pb + 5);
        if (IN(pb + 6)) ph_gemm_out(p, l, lds);
        SEAM(pb + 6);
        if (IN(pb + 7)) ph_norm_route(p, l, lds);
        SEAM(pb + 7);
        if (IN(pb + 8)) ph_scatter(p, l, lds);
        SEAM(pb + 8);
        if (IN(pb + 9)) ph_moe_up(p, l, lds);
        SEAM(pb + 9);
        if (IN(pb + 10)) ph_moe_down(p, l, lds);
        SEAM(pb + 10);
        if (IN(pb + 11)) {
            if (l == 0) { ph_conv_layer(p, 1, lds); ph_combine<false>(p, 0, lds); }
            else ph_combine<true>(p, 1, lds);
        }
        if (l == 0) SEAM(pb + 11);
    }
#undef IN
#undef SEAM
}

extern "C" void kernel_launch(void* const* d_in, const int* in_sizes, int n_in, void* d_out, int out_size, void* d_ws, size_t ws_size, hipStream_t stream) {
    static int grid = 0;
    if (grid == 0) {
        if (n_in != 25 || out_size != T_ * DM || ws_size < WS_END2) { fprintf(stderr, "kernel_launch: unexpected shapes (n_in %d out %d ws %zu)\n", n_in, out_size, ws_size); grid = -1; return; }
        int dev = 0, cus = 0;
        if (hipGetDevice(&dev) != hipSuccess || hipDeviceGetAttribute(&cus, hipDeviceAttributeMultiprocessorCount, dev) != hipSuccess) { grid = -1; return; }
        if (hipFuncSetAttribute((const void*)mega, hipFuncAttributeMaxDynamicSharedMemorySize, LDS_BYTES) != hipSuccess) { fprintf(stderr, "hipFuncSetAttribute failed\n"); grid = -1; return; }
        int per_cu = 0;
        if (hipOccupancyMaxActiveBlocksPerMultiprocessor(&per_cu, (const void*)mega, NTHR, LDS_BYTES) != hipSuccess || per_cu < 1) { fprintf(stderr, "occupancy query: %d\n", per_cu); }
        (void)hipGetLastError();
        grid = cus;
    }
    if (grid < 0) return;
    (void)in_sizes;
    hipMemsetAsync((char*)d_ws + WS_CTL, 0, CTL_ZERO_BYTES, stream);
    Params p{};
    for (int i = 0; i < 25; ++i) p.in[i] = (const float*)d_in[i];
    p.out = (float*)d_out; p.ws = (unsigned char*)d_ws;
#ifndef N_LAUNCH_SPLIT
#define N_LAUNCH_SPLIT 0
#endif
#if N_LAUNCH_SPLIT
    for (int ph = 0; ph < NPHASES; ++ph) { p.ph_lo = ph; p.ph_hi = ph + 1; hipLaunchKernelGGL(mega, dim3(grid), dim3(NTHR), LDS_BYTES, stream, p); }
#else
    p.ph_lo = 0; p.ph_hi = NPHASES; hipLaunchKernelGGL(mega, dim3(grid), dim3(NTHR), LDS_BYTES, stream, p);
#endif
}
```
